# Optimizing an MI355X kernel written in HIP

```python
import jax, jax.numpy as jnp
from jax import lax
import numpy as np

D_MODEL = 2048
BATCH = 4
SEQ = 2048
DEPTH = 4

CHUNK = 64
Q_BLOCK = 128
GLA_HEADS = 4
GLA_DK = D_MODEL // 2 // GLA_HEADS
GLA_DV = D_MODEL // GLA_HEADS
GLA_K = GLA_HEADS * GLA_DK
GLA_V = GLA_HEADS * GLA_DV
GLA_GATE_RANK = 16
GLA_GATE_TAU = 16.0
SB_HEADS = 16
SB_DH = D_MODEL // SB_HEADS
SB_W = SB_HEADS * SB_DH
D_FF = 4 * D_MODEL
EPS = 1e-6
IN_SPLITS = (GLA_K, GLA_K, GLA_V, GLA_V, GLA_GATE_RANK, SB_W, SB_W, SB_W, D_MODEL, D_MODEL)
IN_COLS = GLA_K * 2 + GLA_V * 2 + GLA_GATE_RANK + SB_W * 3 + D_MODEL * 2

kernel_name = "hybrid_gla_stickbreaking_sandwich_adaln"


def rmsnorm(x, gain):
    xf = x.astype(jnp.float32)
    y = xf * lax.rsqrt(jnp.mean(xf * xf, axis=-1, keepdims=True) + EPS)
    return (y * gain.astype(jnp.float32)).astype(x.dtype)


def gla_branch(q, k, v, r, a_low, w_gate_up, b_gate, gn_gain):
    B, S, _ = q.shape
    nc = S // CHUNK
    log_a = jax.nn.log_sigmoid((a_low @ w_gate_up + b_gate).astype(jnp.float32)) / GLA_GATE_TAU

    def heads(t, d):
        return t.astype(jnp.float32).reshape(B, nc, CHUNK, GLA_HEADS, d).transpose(1, 0, 3, 2, 4)

    qh = heads(q, GLA_DK) * (GLA_DK ** -0.5)
    kh = heads(k, GLA_DK)
    vh = heads(v, GLA_DV)
    gh = heads(log_a, GLA_DK)

    def step(state, inp):
        qc, kc, vc, gc = inp
        g = jnp.cumsum(gc, axis=2)
        g_tot = g[:, :, -1:, :]
        kv = jnp.einsum('bhck,bhcv->bhkv', kc * jnp.exp(g_tot - g), vc)
        state = jnp.exp(g_tot[:, :, 0, :, None]) * state + kv
        out = jnp.einsum('bhck,bhkv->bhcv', qc, state)
        return state, out

    s0 = jnp.zeros((B, GLA_HEADS, GLA_DK, GLA_DV), jnp.float32)
    _, o = lax.scan(step, s0, (qh, kh, vh, gh))
    o = o.transpose(1, 0, 3, 2, 4).reshape(B, S, GLA_HEADS, GLA_DV).astype(q.dtype)
    o = rmsnorm(o, gn_gain).reshape(B, S, GLA_V)
    return o * jax.nn.silu(r)


def sb_branch(q, k, v):
    B, S, _ = q.shape

    def heads(t):
        return t.reshape(B, S, SB_HEADS, SB_DH).transpose(0, 2, 1, 3)

    qh, kh, vh = heads(q), heads(k), heads(v)
    scale = SB_DH ** -0.5
    outs = []
    for blk in range(S // Q_BLOCK):
        q0 = blk * Q_BLOCK
        end = q0 + Q_BLOCK
        qb = qh[:, :, q0:end]
        kb = kh[:, :, :end]
        vb = vh[:, :, :end]
        z = jnp.einsum('bhqd,bhkd->bhqk', qb, kb).astype(jnp.float32) * scale
        t_idx = q0 + jnp.arange(Q_BLOCK)[:, None]
        s_idx = jnp.arange(end)[None, :]
        past = s_idx < t_idx
        log_beta = jax.nn.log_sigmoid(z)
        log_1mb = jnp.where(past, jax.nn.log_sigmoid(-z), 0.0)
        after = lax.cumsum(log_1mb, axis=3, reverse=True) - log_1mb
        w = jnp.where(past, jnp.exp(log_beta + after), 0.0)
        outs.append(jnp.einsum('bhqk,bhkd->bhqd', w.astype(vb.dtype), vb))
    o = jnp.concatenate(outs, axis=2)
    return o.transpose(0, 2, 1, 3).reshape(B, S, SB_W)


def setup_inputs(seed: int = 0) -> dict:
    key = jax.random.key(seed)
    ks = jax.random.split(key, 16)
    L, D = DEPTH, D_MODEL

    def nrm(k, shape, fan_in):
        return jax.random.normal(k, shape, jnp.float32) * (fan_in ** -0.5)

    def gain(k, shape):
        return 1.0 + 0.05 * jax.random.normal(k, shape, jnp.float32)

    return {
        "x": jax.random.normal(ks[0], (BATCH, SEQ, D), jnp.float32),
        "c": jax.random.normal(ks[1], (BATCH, D), jnp.float32),
        "w_ada": nrm(ks[2], (L, D, 6 * D), D),
        "b_ada": 0.02 * jax.random.normal(ks[3], (L, 6 * D), jnp.float32),
        "norm_gains": gain(ks[4], (L, 4, D)),
        "w_in": nrm(ks[5], (L, D, IN_COLS), D),
        "w_gate_up": nrm(ks[6], (L, GLA_GATE_RANK, GLA_K), GLA_GATE_RANK),
        "b_gate": 0.1 * jax.random.normal(ks[7], (L, GLA_K), jnp.float32),
        "gla_norm_gain": gain(ks[8], (L, GLA_HEADS, GLA_DV)),
        "w_gla_o": nrm(ks[9], (L, GLA_V, D), GLA_V),
        "w_sb_o": nrm(ks[10], (L, SB_W, D), SB_W),
        "w_out": nrm(ks[11], (L, D, D), D),
        "w_ff1": nrm(ks[12], (L, D, D_FF), D),
        "w_ff2": nrm(ks[13], (L, D_FF, D), D_FF),
    }


def reference(x, c, w_ada, b_ada, norm_gains, w_in, w_gate_up, b_gate, gla_norm_gain,
              w_gla_o, w_sb_o, w_out, w_ff1, w_ff2):
    split_idx = [int(i) for i in np.cumsum(IN_SPLITS)[:-1]]
    c_act = jax.nn.silu(c)
    for l in range(DEPTH):
        mod = (c_act @ w_ada[l] + b_ada[l])[:, None, :]
        sh1, sc1, g1, sh2, sc2, g2 = jnp.split(mod, 6, axis=-1)
        ng = norm_gains[l]

        h = rmsnorm(x, ng[0]) * (1.0 + sc1) + sh1
        proj = h @ w_in[l]
        (q_a, k_a, v_a, r_a, a_low, q_b, k_b, v_b,
         gate_a, gate_b) = jnp.split(proj, split_idx, axis=-1)
        y_a = gla_branch(q_a, k_a, v_a, r_a, a_low, w_gate_up[l], b_gate[l], gla_norm_gain[l]) @ w_gla_o[l]
        y_b = sb_branch(q_b, k_b, v_b) @ w_sb_o[l]
        mixed = jax.nn.sigmoid(gate_a) * y_a + jax.nn.sigmoid(gate_b) * y_b
        x = x + g1 * rmsnorm(mixed @ w_out[l], ng[1])

        h = rmsnorm(x, ng[2]) * (1.0 + sc2) + sh2
        f = jnp.square(jax.nn.relu(h @ w_ff1[l])) @ w_ff2[l]
        x = x + g2 * rmsnorm(f, ng[3])
    return x
```

```cpp
#include <hip/hip_runtime.h>
#include <cstdio>
#include <cstdint>

#ifndef N_LAUNCHES
#define N_LAUNCHES 1
#endif
#ifndef FAST_GEMM
#define FAST_GEMM 0
#endif
#ifndef FAST_GLA
#define FAST_GLA 0
#endif
#ifndef FAST_SB
#define FAST_SB 0
#endif

#define GAS __attribute__((address_space(1)))
#define LAS __attribute__((address_space(3)))
typedef unsigned short bf16;
typedef float f32x4 __attribute__((ext_vector_type(4)));
typedef float f32x2 __attribute__((ext_vector_type(2)));
typedef float f32x16 __attribute__((ext_vector_type(16)));
typedef short bf16x8 __attribute__((ext_vector_type(8)));
typedef unsigned v4u __attribute__((ext_vector_type(4)));
typedef unsigned v2u __attribute__((ext_vector_type(2)));
typedef GAS unsigned gu32;
#define RLX_AGENT __ATOMIC_RELAXED, __HIP_MEMORY_SCOPE_AGENT
#define LDS_WAIT() asm volatile("s_waitcnt lgkmcnt(0)" ::: "memory")
#define VM_WAIT() asm volatile("s_waitcnt vmcnt(0)" ::: "memory")

constexpr int DM = 2048, NB = 4, SEQ = 2048, DEPTH = 4, MTOK = NB * SEQ;
constexpr int GH = 4, GDK = 256, GDV = 512, GK = 1024, GV = 2048, RANK = 16, SH = 16, SDH = 128, DFF = 8192, INCOLS = 16400;
constexpr int C_QA = 0, C_KA = 1024, C_VA = 2048, C_RA = 4096, C_AL = 6144, C_QB = 6160, C_KB = 8208, C_VB = 10256, C_GA = 12304, C_GB = 14352;
constexpr float EPS = 1e-6f;
constexpr int NWAVES = 8, NTHR = 512;

constexpr size_t MiB = 1u << 20;
constexpr size_t WS_CTL = 0, CTL_ZERO_BYTES = 1 * MiB;
constexpr size_t WS_MOD = 1 * MiB;
constexpr size_t WS_WA = 2 * MiB;
constexpr size_t WS_DEC = 3 * MiB;
constexpr size_t WS_W = 4 * MiB;
constexpr size_t WL_IN = 0, WL_GO = 64 * MiB, WL_SO = 72 * MiB, WL_OUT = 80 * MiB, WL_FF1 = 88 * MiB, WL_FF2 = 120 * MiB, WL_STRIDE = 152 * MiB;
constexpr size_t WS_H = 612 * MiB;
constexpr size_t WS_PROJ = 644 * MiB;
constexpr size_t WS_QA = WS_PROJ, WS_RA = WS_QA + 16 * MiB, WS_QB = WS_RA + 32 * MiB, WS_KB = WS_QB + 32 * MiB, WS_GA = WS_KB + 32 * MiB, WS_GB = WS_GA + 32 * MiB,
                 WS_KAT = WS_GB + 32 * MiB, WS_VAT = WS_KAT + 16 * MiB, WS_VBT = WS_VAT + 32 * MiB;
constexpr size_t WS_F1 = WS_PROJ;
constexpr size_t WS_GT = 900 * MiB;
constexpr size_t WS_OG = 916 * MiB, WS_GIN = 948 * MiB, WS_SBO = 980 * MiB;
constexpr size_t WS_TMP = 1012 * MiB;
constexpr size_t WS_MIX = 1076 * MiB;
constexpr size_t WS_M2 = 1108 * MiB;
constexpr size_t WS_END = 1172 * MiB;
static_assert(WS_VBT + 32 * MiB == 900 * MiB, "proj map");

constexpr int CW_TMO = 0, CW_CODE = 1, CW_BAR = 4096;
constexpr int RING_BYTES = 131072, LDSCTL_OFF = RING_BYTES, MISC_OFF = LDSCTL_OFF + 320, LDS_BYTES = 147456;

__device__ __forceinline__ float bf2f(unsigned b) { return __uint_as_float(b << 16); }
__device__ __forceinline__ unsigned f2bf(float f) { unsigned u = __float_as_uint(f); return (u + 0x7fffu + ((u >> 16) & 1u)) >> 16; }
__device__ __forceinline__ unsigned pk2(float lo, float hi) { return f2bf(lo) | (f2bf(hi) << 16); }
__device__ __forceinline__ float wave_sum(float v) {
#pragma unroll
    for (int o = 1; o < 64; o <<= 1) v += __shfl_xor(v, o);
    return v;
}
__device__ __forceinline__ float sigmoidf_(float v) { return __builtin_amdgcn_rcpf(1.f + __expf(-v)); }
__device__ __forceinline__ float logsig(float x) { return fminf(x, 0.f) - __logf(1.f + __expf(-fabsf(x))); }

#define XB_TMO      128
#define XB_XCNT(j)  (256  + 64 * (j))
#define XB_XSUB(j)  (1280 + 64 * (j))
#define XB_XGEN(j)  (2304 + 64 * (j))
#define XB_TOP      3328
#define XB_TOPGEN   3392
#define XCD_BAR_WORDS 3456
#define XB_SPIN_CAP (1u << 22)
__device__ __forceinline__ unsigned xb_ld(unsigned* p)              { return __hip_atomic_load(p, __ATOMIC_RELAXED, __HIP_MEMORY_SCOPE_AGENT); }
__device__ __forceinline__ unsigned xb_add(unsigned* p, unsigned v) { return __hip_atomic_fetch_add(p, v, __ATOMIC_RELAXED, __HIP_MEMORY_SCOPE_AGENT); }
__device__ __forceinline__ unsigned xb_xcc_id() { return (unsigned)__builtin_amdgcn_s_getreg((3 << 11) | 20) & 0xFu; }
#define XB_SPIN(cond, bar) do { unsigned _sp = 0; while (cond) { __builtin_amdgcn_s_sleep(1); \
    if ((++_sp & 255u) == 0u) { if (xb_ld(&(bar)[XB_TMO])) break; if (_sp > XB_SPIN_CAP) { atomicAdd(&(bar)[XB_TMO], 1u); break; } } } } while (0)
struct XcdBarrier { unsigned* bar; unsigned x; volatile LAS unsigned* st; };
__device__ __forceinline__ XcdBarrier xcd_barrier_post(unsigned* bar, volatile LAS unsigned* st) {
    XcdBarrier b; b.bar = bar; b.x = xb_xcc_id(); b.st = st;
    if (threadIdx.x == 0) (void)xb_add(&bar[XB_XCNT(b.x)], 1u);
    return b;
}
__device__ __forceinline__ void xcd_barrier_complete(unsigned* bar, unsigned x, unsigned& nloc, unsigned& nx) {
    const unsigned G = gridDim.x * gridDim.y * gridDim.z;
    unsigned sum, cnt, mine, sp = 0u;
    for (;;) {
        sum = 0u; cnt = 0u; mine = 0u;
#pragma unroll
        for (unsigned j = 0; j < 16; ++j) { const unsigned c = xb_ld(&bar[XB_XCNT(j)]); sum += c; cnt += (c > 0u) ? 1u : 0u; mine = (j == x) ? c : mine; }
        if (sum == G) break;
        __builtin_amdgcn_s_sleep(1);
        if ((++sp & 255u) == 0u) { if (xb_ld(&bar[XB_TMO])) break; if (sp > XB_SPIN_CAP) { atomicAdd(&bar[XB_TMO], 1u); break; } }
    }
    nloc = mine > 0u ? mine : 1u; nx = cnt > 0u ? cnt : 1u;
}
__device__ __forceinline__ void xcd_barrier(const XcdBarrier& b) {
    asm volatile("s_waitcnt vmcnt(0)" ::: "memory");
    __syncthreads();
    if (threadIdx.x == 0) {
        unsigned* bar = b.bar;
        __builtin_amdgcn_s_waitcnt(0);
        unsigned nloc = b.st[0], nx = b.st[1];
        if (nloc == 0u) { xcd_barrier_complete(bar, b.x, nloc, nx); b.st[0] = nloc; b.st[1] = nx; }
        const unsigned old = xb_add(&bar[XB_XSUB(b.x)], 1u);
        const unsigned gen = old / nloc;
        if (old + 1u == (gen + 1u) * nloc) {
            __builtin_amdgcn_fence(__ATOMIC_RELEASE, "agent");
            asm volatile("s_waitcnt vmcnt(0)" ::: "memory");
            const unsigned og = xb_add(&bar[XB_TOP], 1u);
            const unsigned tg = og / nx;
            if (og + 1u == (tg + 1u) * nx) xb_add(&bar[XB_TOPGEN], 1u);
            else XB_SPIN(xb_ld(&bar[XB_TOPGEN]) == tg, bar);
            __builtin_amdgcn_fence(__ATOMIC_ACQUIRE, "agent");
            xb_add(&bar[XB_XGEN(b.x)], 1u);
            asm volatile("s_waitcnt vmcnt(0)" ::: "memory");
        } else {
            XB_SPIN(xb_ld(&bar[XB_XGEN(b.x)]) == gen, bar);
            __builtin_amdgcn_fence(__ATOMIC_ACQUIRE, "agent");
            asm volatile("s_waitcnt vmcnt(0)" ::: "memory");
        }
    }
    __syncthreads();
}

struct Frame {
    LAS unsigned char* lds;
    int tid, lane, wave, G, bx;
    const float *x, *c, *w_ada, *b_ada, *ng, *w_in, *w_gu, *b_gate, *gn, *w_go, *w_so, *w_out, *w_ff1, *w_ff2;
    float* out; unsigned char* ws;
};
#define WSP(T, off) ((T*)(F.ws + (off)))

template <class Epi>
__device__ __forceinline__ void gold_gemm(Frame& F, const bf16* A, int lda, const float* W, int ldw, int Mrows, int N, int K, const Epi& epi) {
    const int gw = F.bx * NWAVES + F.wave, ngw = F.G * NWAVES, lane = F.lane, r = lane & 31, h = lane >> 5;
    const int tm = Mrows / 64, tn = (N + 63) / 64;
    for (int u = gw; u < tm * tn; u += ngw) {
        const int m0 = (u / tn) * 64, n0 = (u % tn) * 64;
        f32x16 acc[2][2];
#pragma unroll
        for (int i = 0; i < 2; ++i)
#pragma unroll
            for (int j = 0; j < 2; ++j)
#pragma unroll
                for (int e = 0; e < 16; ++e) acc[i][j][e] = 0.f;
        const int nc0 = (n0 + r < N) ? n0 + r : N - 1, nc1 = (n0 + 32 + r < N) ? n0 + 32 + r : N - 1;
        const bf16* a0p = A + (size_t)(m0 + r) * lda + 8 * h; const bf16* a1p = A + (size_t)(m0 + 32 + r) * lda + 8 * h;
        for (int k0 = 0; k0 < K; k0 += 16) {
            const bf16x8 a0 = *(const bf16x8*)(a0p + k0), a1 = *(const bf16x8*)(a1p + k0);
            bf16x8 b0, b1;
#pragma unroll
            for (int j = 0; j < 8; ++j) { const float* wr = W + (size_t)(k0 + 8 * h + j) * ldw; b0[j] = (short)f2bf(wr[nc0]); b1[j] = (short)f2bf(wr[nc1]); }
            acc[0][0] = __builtin_amdgcn_mfma_f32_32x32x16_bf16(a0, b0, acc[0][0], 0, 0, 0);
            acc[0][1] = __builtin_amdgcn_mfma_f32_32x32x16_bf16(a0, b1, acc[0][1], 0, 0, 0);
            acc[1][0] = __builtin_amdgcn_mfma_f32_32x32x16_bf16(a1, b0, acc[1][0], 0, 0, 0);
            acc[1][1] = __builtin_amdgcn_mfma_f32_32x32x16_bf16(a1, b1, acc[1][1], 0, 0, 0);
        }
#pragma unroll
        for (int i = 0; i < 2; ++i)
#pragma unroll
            for (int j = 0; j < 2; ++j)
#pragma unroll
                for (int e = 0; e < 16; ++e) { const int row = m0 + 32 * i + (e & 3) + 8 * (e >> 2) + 4 * h, col = n0 + 32 * j + r; if (col < N) epi(row, col, acc[i][j][e]); }
    }
}
struct GEpiProj { bf16 *QA, *RA, *QB, *KB, *GA, *GB, *KAT, *VAT, *VBT;
    __device__ __forceinline__ void operator()(int row, int col, float v) const {
        if (col < C_KA) QA[(size_t)row * GK + col] = (bf16)f2bf(v * 0.0625f);
        else if (col < C_VA) KAT[(size_t)(col - C_KA) * MTOK + row] = (bf16)f2bf(v);
        else if (col < C_RA) VAT[(size_t)(col - C_VA) * MTOK + row] = (bf16)f2bf(v);
        else if (col < C_AL) RA[(size_t)row * GV + col - C_RA] = (bf16)f2bf(v * sigmoidf_(v));
        else if (col < C_QB) { }
        else if (col < C_KB) QB[(size_t)row * DM + col - C_QB] = (bf16)f2bf(v * 0.08838834764831845f);
        else if (col < C_VB) KB[(size_t)row * DM + col - C_KB] = (bf16)f2bf(v);
        else if (col < C_GA) VBT[(size_t)(col - C_VB) * MTOK + row] = (bf16)f2bf(v);
        else if (col < C_GB) GA[(size_t)row * DM + col - C_GA] = (bf16)f2bf(sigmoidf_(v));
        else GB[(size_t)row * DM + col - C_GB] = (bf16)f2bf(sigmoidf_(v));
    } };
struct GEpiGateA { float* TMP; const bf16* GA; __device__ __forceinline__ void operator()(int row, int col, float v) const { const size_t i = (size_t)row * DM + col; TMP[i] = v * bf2f(GA[i]); } };
struct GEpiGateB { const float* TMP; const bf16* GB; bf16* MIX; __device__ __forceinline__ void operator()(int row, int col, float v) const { const size_t i = (size_t)row * DM + col; MIX[i] = (bf16)f2bf(TMP[i] + v * bf2f(GB[i])); } };
struct GEpiF32 { float* C; int ldc; __device__ __forceinline__ void operator()(int row, int col, float v) const { C[(size_t)row * ldc + col] = v; } };
struct GEpiRelu2 { bf16* O; int ldc; __device__ __forceinline__ void operator()(int row, int col, float v) const { const float t = fmaxf(v, 0.f); O[(size_t)row * ldc + col] = (bf16)f2bf(t * t); } };

__device__ __forceinline__ void p0_mod(Frame& F) {
    LAS float* cact = (LAS float*)F.lds;
    LAS float* red = (LAS float*)(F.lds + 32768);
    for (int i = F.tid; i < NB * DM; i += NTHR) { const float v = F.c[i]; cact[i] = v * sigmoidf_(v); }
    __syncthreads();
    float* MOD = WSP(float, WS_MOD);
    for (int u = F.bx; u < DEPTH * 48; u += F.G) {
        const int l = u / 48, n0 = (u % 48) * 256;
        const float* W = F.w_ada + (size_t)l * DM * (6 * DM) + n0 + 4 * F.lane;
        f32x4 acc[4];
#pragma unroll
        for (int b = 0; b < 4; ++b) acc[b] = (f32x4){0.f, 0.f, 0.f, 0.f};
        const int kb = F.wave * 256;
#pragma unroll 8
        for (int k = 0; k < 256; ++k) {
            const f32x4 wv = *(const f32x4*)(W + (size_t)(kb + k) * (6 * DM));
#pragma unroll
            for (int b = 0; b < 4; ++b) acc[b] += cact[b * DM + kb + k] * wv;
        }
#pragma unroll
        for (int b = 0; b < 4; ++b) *(LAS f32x4*)(red + (F.wave * 4 + b) * 256 + 4 * F.lane) = acc[b];
        __syncthreads();
#pragma unroll
        for (int i = 0; i < 2; ++i) {
            const int o = F.tid * 2 + i, b = o >> 8, col = o & 255; float s = F.b_ada[(size_t)l * 6 * DM + n0 + col];
#pragma unroll
            for (int w = 0; w < 8; ++w) s += red[(w * 4 + b) * 256 + col];
            MOD[(size_t)(l * NB + b) * (6 * DM) + n0 + col] = s;
        }
        __syncthreads();
    }
}

__device__ __forceinline__ void row_load(const float* p, int lane, f32x4 (&v)[8]) {
#pragma unroll
    for (int j = 0; j < 8; ++j) v[j] = *(const f32x4*)(p + 256 * j + 4 * lane);
}
__device__ __forceinline__ float row_rstd(const f32x4 (&v)[8]) {
    float s = 0.f;
#pragma unroll
    for (int j = 0; j < 8; ++j) s += (v[j].x * v[j].x + v[j].y * v[j].y) + (v[j].z * v[j].z + v[j].w * v[j].w);
    return rsqrtf(wave_sum(s) * (1.f / DM) + EPS);
}
__device__ __forceinline__ void row_emit_h(const f32x4 (&x)[8], const float* ng, const float* sc, const float* sh, bf16* hrow, int lane) {
    const float rs = row_rstd(x);
#pragma unroll
    for (int j = 0; j < 8; ++j) {
        const int o = 256 * j + 4 * lane;
        const f32x4 g = *(const f32x4*)(ng + o), s = *(const f32x4*)(sc + o), t = *(const f32x4*)(sh + o);
        const f32x4 hv = x[j] * rs * g * (1.f + s) + t;
        v2u w; w.x = pk2(hv.x, hv.y); w.y = pk2(hv.z, hv.w);
        *(v2u*)(hrow + o) = w;
    }
}
template <int MODE> __device__ __forceinline__ void row_phase(Frame& F, int l) {
    const int gw = F.bx * NWAVES + F.wave, ngw = F.G * NWAVES, lane = F.lane;
    const float* MOD = WSP(float, WS_MOD); bf16* H = WSP(bf16, WS_H); const float* M2 = WSP(float, WS_M2);
    for (int m = gw; m < MTOK; m += ngw) {
        const int b = m / SEQ; const float* modp = MOD + (size_t)(l * NB + b) * (6 * DM);
        f32x4 x[8];
        if (MODE == 0) {
            row_load(F.x + (size_t)m * DM, lane, x);
            row_emit_h(x, F.ng + (size_t)(l * 4 + 0) * DM, modp + DM, modp, H + (size_t)m * DM, lane);
        } else {
            const float* xs = ((MODE == 1 && l == 0) ? F.x : F.out) + (size_t)m * DM;
            row_load(xs, lane, x);
            f32x4 y[8]; row_load(M2 + (size_t)m * DM, lane, y);
            const float rs = row_rstd(y);
            const float* g = modp + (MODE == 1 ? 2 * DM : 5 * DM); const float* ngy = F.ng + (size_t)(l * 4 + (MODE == 1 ? 1 : 3)) * DM;
#pragma unroll
            for (int j = 0; j < 8; ++j) { const int o = 256 * j + 4 * lane; const f32x4 gv = *(const f32x4*)(g + o), nv = *(const f32x4*)(ngy + o);
                x[j] = x[j] + gv * (y[j] * rs * nv); *(f32x4*)(F.out + (size_t)m * DM + o) = x[j]; }
            if (MODE == 1) row_emit_h(x, F.ng + (size_t)(l * 4 + 2) * DM, modp + 4 * DM, modp + 3 * DM, H + (size_t)m * DM, lane);
            else if (l + 1 < DEPTH) { const float* modn = MOD + (size_t)((l + 1) * NB + b) * (6 * DM);
                row_emit_h(x, F.ng + (size_t)((l + 1) * 4 + 0) * DM, modn + DM, modn, H + (size_t)m * DM, lane); }
        }
    }
}

__device__ __forceinline__ void gcalc(Frame& F, int l) {
    LAS float* al = (LAS float*)F.lds;
    const bf16* H = WSP(bf16, WS_H); bf16* GT = WSP(bf16, WS_GT); float* DEC = WSP(float, WS_DEC);
    for (int u = F.bx; u < 256; u += F.G) {
        const int cc = u >> 1, kd = (u & 1) * 512 + F.tid;
        {
            const int t = F.tid >> 3, r0 = (F.tid & 7) * 2; float a0 = 0.f, a1 = 0.f;
            const bf16* hp = H + (size_t)(cc * 64 + t) * DM; const float* wp = F.w_in + (size_t)l * DM * INCOLS + C_AL + r0;
            for (int k0 = 0; k0 < DM; k0 += 8) {
                const v4u hv = *(const v4u*)(hp + k0);
                const float hh[8] = {bf2f(hv.x & 0xffffu), bf2f(hv.x >> 16), bf2f(hv.y & 0xffffu), bf2f(hv.y >> 16), bf2f(hv.z & 0xffffu), bf2f(hv.z >> 16), bf2f(hv.w & 0xffffu), bf2f(hv.w >> 16)};
#pragma unroll
                for (int i = 0; i < 8; ++i) { const f32x2 w = *(const f32x2*)(wp + (size_t)(k0 + i) * INCOLS); a0 += hh[i] * bf2f(f2bf(w.x)); a1 += hh[i] * bf2f(f2bf(w.y)); }
            }
            al[t * 16 + r0] = a0; al[t * 16 + r0 + 1] = a1;
        }
        __syncthreads();
        float wg[16];
#pragma unroll
        for (int r = 0; r < 16; ++r) wg[r] = F.w_gu[(size_t)(l * RANK + r) * GK + kd];
        const float bg = F.b_gate[(size_t)l * GK + kd];
        float la[64];
#pragma unroll
        for (int t = 0; t < 64; ++t) { float s = bg;
#pragma unroll
            for (int r = 0; r < 16; ++r) s += al[t * 16 + r] * wg[r];
            la[t] = logsig(s) * 0.0625f; }
        float suf = 0.f;
#pragma unroll
        for (int t8 = 7; t8 >= 0; --t8) { float g[8];
#pragma unroll
            for (int i = 7; i >= 0; --i) { g[i] = __expf(suf); suf += la[t8 * 8 + i]; }
            v4u w; w.x = pk2(g[0], g[1]); w.y = pk2(g[2], g[3]); w.z = pk2(g[4], g[5]); w.w = pk2(g[6], g[7]);
            *(v4u*)(GT + (size_t)kd * MTOK + cc * 64 + t8 * 8) = w; }
        DEC[(size_t)cc * GK + kd] = __expf(suf);
        __syncthreads();
    }
}

__device__ __forceinline__ void gla_gold(Frame& F) {
    LAS float* S = (LAS float*)F.lds;
    LAS float* vv = (LAS float*)(F.lds + 33792);
    LAS bf16* kp = (LAS bf16*)(F.lds + 33792 + 8320);
    LAS bf16* qq = (LAS bf16*)(F.lds + 33792 + 8320 + 33792);
    const bf16* KAT = WSP(bf16, WS_KAT); const bf16* GT = WSP(bf16, WS_GT); const bf16* VAT = WSP(bf16, WS_VAT); const bf16* QA = WSP(bf16, WS_QA);
    const float* DEC = WSP(float, WS_DEC); bf16* OG = WSP(bf16, WS_OG);
    for (int u = F.bx; u < 256; u += F.G) {
        const int b = u >> 6, hg = (u >> 4) & 3, vs = u & 15;
        for (int i = F.tid; i < 256 * 33; i += NTHR) S[i] = 0.f;
        __syncthreads();
        for (int c = 0; c < 32; ++c) {
            const int T0 = b * SEQ + c * 64, cc = b * 32 + c;
            { const int k = F.tid >> 1, t0 = (F.tid & 1) * 32; const size_t go = (size_t)(hg * GDK + k) * MTOK + T0 + t0;
#pragma unroll
              for (int i = 0; i < 32; ++i) kp[k * 66 + t0 + i] = (bf16)f2bf(bf2f(KAT[go + i]) * bf2f(GT[go + i])); }
            { const int v = F.tid >> 4, t0 = (F.tid & 15) * 4; const size_t go = (size_t)(hg * GDV + vs * 32 + v) * MTOK + T0 + t0;
#pragma unroll
              for (int i = 0; i < 4; ++i) vv[v * 65 + t0 + i] = bf2f(VAT[go + i]); }
            { const int t = F.tid >> 3, k0 = (F.tid & 7) * 32; const size_t go = (size_t)(T0 + t) * GK + hg * GDK + k0;
#pragma unroll
              for (int i = 0; i < 32; ++i) qq[t * 258 + k0 + i] = QA[go + i]; }
            __syncthreads();
#pragma unroll 1
            for (int i = 0; i < 16; ++i) { const int e = F.tid + 512 * i, k = e >> 5, v = e & 31;
                float acc = S[k * 33 + v] * DEC[(size_t)cc * GK + hg * GDK + k];
                for (int t = 0; t < 64; ++t) acc += bf2f(kp[k * 66 + t]) * vv[v * 65 + t];
                S[k * 33 + v] = acc; }
            __syncthreads();
#pragma unroll 1
            for (int i = 0; i < 4; ++i) { const int e = F.tid + 512 * i, t = e >> 5, v = e & 31; float acc = 0.f;
                for (int k = 0; k < 256; ++k) acc += bf2f(qq[t * 258 + k]) * S[k * 33 + v];
                OG[(size_t)(T0 + t) * GV + hg * GDV + vs * 32 + v] = (bf16)f2bf(acc); }
            __syncthreads();
        }
    }
}

__device__ __forceinline__ void sb_gold(Frame& F) {
    const int gw = F.bx * NWAVES + F.wave, ngw = F.G * NWAVES, lane = F.lane;
    const bf16* QB = WSP(bf16, WS_QB); const bf16* KB = WSP(bf16, WS_KB); const bf16* VBT = WSP(bf16, WS_VBT); bf16* SBO = WSP(bf16, WS_SBO);
    for (int rid = gw; rid < NB * SH * SEQ; rid += ngw) {
        const int t = rid % SEQ, bh = rid / SEQ, b = bh / SH, h = bh % SH;
        const unsigned qw = *(const unsigned*)(QB + (size_t)(b * SEQ + t) * DM + h * SDH + 2 * lane);
        const float q0 = bf2f(qw & 0xffffu), q1 = bf2f(qw >> 16);
        float o0 = 0.f, o1 = 0.f, P = 1.f;
        const bf16* v0p = VBT + (size_t)(h * SDH + 2 * lane) * MTOK + b * SEQ; const bf16* v1p = v0p + MTOK;
        for (int s = t - 1; s >= 0; --s) {
            if (P == 0.f) break;
            const unsigned kw = *(const unsigned*)(KB + (size_t)(b * SEQ + s) * DM + h * SDH + 2 * lane);
            float z = wave_sum(q0 * bf2f(kw & 0xffffu) + q1 * bf2f(kw >> 16));
            z = fminf(fmaxf(z, -80.f), 80.f);
            const float e = __expf(-z), beta = __builtin_amdgcn_rcpf(1.f + e), w = beta * P;
            P *= e * beta;
            o0 += w * bf2f(v0p[s]); o1 += w * bf2f(v1p[s]);
        }
        *(unsigned*)(SBO + (size_t)(b * SEQ + t) * DM + h * SDH + 2 * lane) = pk2(o0, o1);
    }
}

__device__ __forceinline__ void gla_gate(Frame& F, int l) {
    const int gw = F.bx * NWAVES + F.wave, ngw = F.G * NWAVES, lane = F.lane;
    const bf16* OG = WSP(bf16, WS_OG); const bf16* RA = WSP(bf16, WS_RA); bf16* GIN = WSP(bf16, WS_GIN);
    for (int m = gw; m < MTOK; m += ngw) {
#pragma unroll
        for (int hg = 0; hg < 4; ++hg) {
            const size_t o = (size_t)m * GV + hg * GDV + 8 * lane;
            const v4u ov = *(const v4u*)(OG + o), rv = *(const v4u*)(RA + o);
            float x[8]; x[0] = bf2f(ov.x & 0xffffu); x[1] = bf2f(ov.x >> 16); x[2] = bf2f(ov.y & 0xffffu); x[3] = bf2f(ov.y >> 16);
            x[4] = bf2f(ov.z & 0xffffu); x[5] = bf2f(ov.z >> 16); x[6] = bf2f(ov.w & 0xffffu); x[7] = bf2f(ov.w >> 16);
            float r[8]; r[0] = bf2f(rv.x & 0xffffu); r[1] = bf2f(rv.x >> 16); r[2] = bf2f(rv.y & 0xffffu); r[3] = bf2f(rv.y >> 16);
            r[4] = bf2f(rv.z & 0xffffu); r[5] = bf2f(rv.z >> 16); r[6] = bf2f(rv.w & 0xffffu); r[7] = bf2f(rv.w >> 16);
            float s = 0.f;
#pragma unroll
            for (int i = 0; i < 8; ++i) s += x[i] * x[i];
            const float rs = rsqrtf(wave_sum(s) * (1.f / GDV) + EPS);
            const float* gp = F.gn + (size_t)(l * GH + hg) * GDV + 8 * lane;
            const f32x4 g0 = *(const f32x4*)gp, g1 = *(const f32x4*)(gp + 4);
            const float gg[8] = {g0.x, g0.y, g0.z, g0.w, g1.x, g1.y, g1.z, g1.w};
            float y[8];
#pragma unroll
            for (int i = 0; i < 8; ++i) y[i] = x[i] * rs * gg[i] * r[i];
            v4u w; w.x = pk2(y[0], y[1]); w.y = pk2(y[2], y[3]); w.z = pk2(y[4], y[5]); w.w = pk2(y[6], y[7]);
            *(v4u*)(GIN + o) = w;
        }
    }
}

constexpr int NPHASE = 2 + 9 * DEPTH;
struct Args { const float* in[14]; float* out; unsigned char* ws; int ph_lo, ph_hi, use_bar, pad; };
__global__ void __launch_bounds__(NTHR, 2) fwd(Args args) {
    extern __shared__ __attribute__((aligned(16))) unsigned char lds[];
    Frame F;
    F.lds = (LAS unsigned char*)lds; F.tid = threadIdx.x; F.lane = F.tid & 63; F.wave = __builtin_amdgcn_readfirstlane(F.tid >> 6); F.G = gridDim.x; F.bx = blockIdx.x;
    F.x = args.in[0]; F.c = args.in[1]; F.w_ada = args.in[2]; F.b_ada = args.in[3]; F.ng = args.in[4]; F.w_in = args.in[5]; F.w_gu = args.in[6]; F.b_gate = args.in[7];
    F.gn = args.in[8]; F.w_go = args.in[9]; F.w_so = args.in[10]; F.w_out = args.in[11]; F.w_ff1 = args.in[12]; F.w_ff2 = args.in[13]; F.out = args.out; F.ws = args.ws;
    volatile LAS unsigned* MISC = (volatile LAS unsigned*)(F.lds + MISC_OFF);
    for (int u = F.tid; u < (LDS_BYTES - LDSCTL_OFF) / 4; u += NTHR) ((LAS unsigned*)(F.lds + LDSCTL_OFF))[u] = 0u;
    __syncthreads();
    XcdBarrier bar; bar.bar = (unsigned*)(F.ws + WS_CTL) + CW_BAR; bar.x = 0; bar.st = nullptr;
    if (args.use_bar) bar = xcd_barrier_post((unsigned*)(F.ws + WS_CTL) + CW_BAR, MISC + 8);
    const int lo = args.ph_lo, hi = args.ph_hi;
#define IN(k) (lo <= (k) && (k) < hi)
#define SEAM(k) do { if (IN(k) && IN((k) + 1)) xcd_barrier(bar); } while (0)

    if (IN(0)) { p0_mod(F); } SEAM(0);
    if (IN(1)) { row_phase<0>(F, 0); } SEAM(1);
    for (int l = 0; l < DEPTH; ++l) {
        const int pb = 2 + 9 * l;
        if (IN(pb + 0)) {
            gcalc(F, l);
            GEpiProj E{WSP(bf16, WS_QA), WSP(bf16, WS_RA), WSP(bf16, WS_QB), WSP(bf16, WS_KB), WSP(bf16, WS_GA), WSP(bf16, WS_GB), WSP(bf16, WS_KAT), WSP(bf16, WS_VAT), WSP(bf16, WS_VBT)};
            gold_gemm(F, WSP(bf16, WS_H), DM, F.w_in + (size_t)l * DM * INCOLS, INCOLS, MTOK, INCOLS, DM, E);
        } SEAM(pb + 0);
        if (IN(pb + 1)) {
            gla_gold(F);
            __syncthreads();
            sb_gold(F);
        } SEAM(pb + 1);
        if (IN(pb + 2)) { gla_gate(F, l); } SEAM(pb + 2);
        if (IN(pb + 3)) {
            GEpiGateA EA{WSP(float, WS_TMP), WSP(bf16, WS_GA)};
            gold_gemm(F, WSP(bf16, WS_GIN), GV, F.w_go + (size_t)l * GV * DM, DM, MTOK, DM, GV, EA);
            GEpiGateB EB{WSP(float, WS_TMP), WSP(bf16, WS_GB), WSP(bf16, WS_MIX)};
            gold_gemm(F, WSP(bf16, WS_SBO), DM, F.w_so + (size_t)l * DM * DM, DM, MTOK, DM, DM, EB);
        } SEAM(pb + 3);
        if (IN(pb + 4)) {
            GEpiF32 E{WSP(float, WS_M2), DM};
            gold_gemm(F, WSP(bf16, WS_MIX), DM, F.w_out + (size_t)l * DM * DM, DM, MTOK, DM, DM, E);
        } SEAM(pb + 4);
        if (IN(pb + 5)) { row_phase<1>(F, l); } SEAM(pb + 5);
        if (IN(pb + 6)) {
            GEpiRelu2 E{WSP(bf16, WS_F1), DFF};
            gold_gemm(F, WSP(bf16, WS_H), DM, F.w_ff1 + (size_t)l * DM * DFF, DFF, MTOK, DFF, DM, E);
        } SEAM(pb + 6);
        if (IN(pb + 7)) {
            GEpiF32 E{WSP(float, WS_M2), DM};
            gold_gemm(F, WSP(bf16, WS_F1), DFF, F.w_ff2 + (size_t)l * DFF * DM, DM, MTOK, DM, DFF, E);
        } SEAM(pb + 7);
        if (IN(pb + 8)) { row_phase<2>(F, l); } SEAM(pb + 8);
    }
#undef IN
#undef SEAM
}

extern "C" void kernel_launch(void* const* d_in, const int* in_sizes, int n_in, void* d_out, int out_size, void* d_ws, size_t ws_size, hipStream_t stream) {
    static int grid = 0;
    if (grid == 0) {
        if (n_in != 14 || out_size != MTOK * DM || ws_size < WS_END) { fprintf(stderr, "kernel_launch: unexpected shapes (n_in %d out %d ws %zu)\n", n_in, out_size, ws_size); grid = -1; return; }
        int dev = 0, cus = 0, per_cu = 0;
        if (hipGetDevice(&dev) != hipSuccess || hipDeviceGetAttribute(&cus, hipDeviceAttributeMultiprocessorCount, dev) != hipSuccess) { grid = -1; return; }
        if (hipFuncSetAttribute((const void*)fwd, hipFuncAttributeMaxDynamicSharedMemorySize, LDS_BYTES) != hipSuccess) { fprintf(stderr, "kernel_launch: hipFuncSetAttribute failed\n"); grid = -1; return; }
        if (hipOccupancyMaxActiveBlocksPerMultiprocessor(&per_cu, (const void*)fwd, NTHR, LDS_BYTES) != hipSuccess || per_cu < 1) fprintf(stderr, "kernel_launch: occupancy query says %d\n", per_cu);
        (void)hipGetLastError();
        grid = cus;
    }
    if (grid < 0) return;
    (void)hipMemsetAsync((char*)d_ws + WS_CTL, 0, CTL_ZERO_BYTES, stream);
    Args a{};
    for (int i = 0; i < 14; ++i) a.in[i] = (const float*)d_in[i];
    a.out = (float*)d_out; a.ws = (unsigned char*)d_ws;
#if N_LAUNCHES == 1
    a.ph_lo = 0; a.ph_hi = NPHASE; a.use_bar = 1;
    hipLaunchKernelGGL(fwd, dim3(grid), dim3(NTHR), LDS_BYTES, stream, a);
#else
    for (int p = 0; p < NPHASE; ++p) { a.ph_lo = p; a.ph_hi = p + 1; a.use_bar = 0; hipLaunchKernelGGL(fwd, dim3(grid), dim3(NTHR), LDS_BYTES, stream, a); }
#endif
}
```

```cpp
#include <hip/hip_runtime.h>
#include <cstdio>
#include <cstdint>

#ifndef N_LAUNCHES
#define N_LAUNCHES 1
#endif
#ifndef FAST_GEMM
#define FAST_GEMM 31
#endif
#ifndef FAST_GLA
#define FAST_GLA 0
#endif
#ifndef FAST_SB
#define FAST_SB 0
#endif

#define GAS __attribute__((address_space(1)))
#define LAS __attribute__((address_space(3)))
typedef unsigned short bf16;
typedef float f32x4 __attribute__((ext_vector_type(4)));
typedef float f32x2 __attribute__((ext_vector_type(2)));
typedef float f32x16 __attribute__((ext_vector_type(16)));
typedef short bf16x8 __attribute__((ext_vector_type(8)));
typedef unsigned v4u __attribute__((ext_vector_type(4)));
typedef unsigned v2u __attribute__((ext_vector_type(2)));
typedef GAS unsigned gu32;
#define RLX_AGENT __ATOMIC_RELAXED, __HIP_MEMORY_SCOPE_AGENT
#define LDS_WAIT() asm volatile("s_waitcnt lgkmcnt(0)" ::: "memory")
#define VM_WAIT() asm volatile("s_waitcnt vmcnt(0)" ::: "memory")

constexpr int DM = 2048, NB = 4, SEQ = 2048, DEPTH = 4, MTOK = NB * SEQ;
constexpr int GH = 4, GDK = 256, GDV = 512, GK = 1024, GV = 2048, RANK = 16, SH = 16, SDH = 128, DFF = 8192, INCOLS = 16400;
constexpr int C_QA = 0, C_KA = 1024, C_VA = 2048, C_RA = 4096, C_AL = 6144, C_QB = 6160, C_KB = 8208, C_VB = 10256, C_GA = 12304, C_GB = 14352;
constexpr float EPS = 1e-6f;
constexpr int NWAVES = 8, NTHR = 512;

constexpr size_t MiB = 1u << 20;
constexpr size_t WS_CTL = 0, CTL_ZERO_BYTES = 1 * MiB;
constexpr size_t WS_MOD = 1 * MiB;
constexpr size_t WS_WA = 2 * MiB;
constexpr size_t WS_DEC = 3 * MiB;
constexpr size_t WS_W = 4 * MiB;
constexpr size_t WL_IN = 0, WL_GO = 64 * MiB, WL_SO = 72 * MiB, WL_OUT = 80 * MiB, WL_FF1 = 88 * MiB, WL_FF2 = 120 * MiB, WL_STRIDE = 152 * MiB;
constexpr size_t WS_H = 612 * MiB;
constexpr size_t WS_PROJ = 644 * MiB;
constexpr size_t WS_QA = WS_PROJ, WS_RA = WS_QA + 16 * MiB, WS_QB = WS_RA + 32 * MiB, WS_KB = WS_QB + 32 * MiB, WS_GA = WS_KB + 32 * MiB, WS_GB = WS_GA + 32 * MiB,
                 WS_KAT = WS_GB + 32 * MiB, WS_VAT = WS_KAT + 16 * MiB, WS_VBT = WS_VAT + 32 * MiB;
constexpr size_t WS_F1 = WS_PROJ;
constexpr size_t WS_GT = 900 * MiB;
constexpr size_t WS_OG = 916 * MiB, WS_GIN = 948 * MiB, WS_SBO = 980 * MiB;
constexpr size_t WS_TMP = 1012 * MiB;
constexpr size_t WS_MIX = 1076 * MiB;
constexpr size_t WS_M2 = 1108 * MiB;
constexpr size_t WS_END = 1172 * MiB;
static_assert(WS_VBT + 32 * MiB == 900 * MiB, "proj map");

constexpr int CW_TMO = 0, CW_CODE = 1, CW_BAR = 4096;
constexpr int RING_BYTES = 131072, LDSCTL_OFF = RING_BYTES, MISC_OFF = LDSCTL_OFF + 320, LDS_BYTES = 147456;

__device__ __forceinline__ float bf2f(unsigned b) { return __uint_as_float(b << 16); }
__device__ __forceinline__ unsigned f2bf(float f) { unsigned u = __float_as_uint(f); return (u + 0x7fffu + ((u >> 16) & 1u)) >> 16; }
__device__ __forceinline__ unsigned pk2(float lo, float hi) { return f2bf(lo) | (f2bf(hi) << 16); }
__device__ __forceinline__ float wave_sum(float v) {
#pragma unroll
    for (int o = 1; o < 64; o <<= 1) v += __shfl_xor(v, o);
    return v;
}
__device__ __forceinline__ float sigmoidf_(float v) { return __builtin_amdgcn_rcpf(1.f + __expf(-v)); }
__device__ __forceinline__ float logsig(float x) { return fminf(x, 0.f) - __logf(1.f + __expf(-fabsf(x))); }

#define XB_TMO      128
#define XB_XCNT(j)  (256  + 64 * (j))
#define XB_XSUB(j)  (1280 + 64 * (j))
#define XB_XGEN(j)  (2304 + 64 * (j))
#define XB_TOP      3328
#define XB_TOPGEN   3392
#define XCD_BAR_WORDS 3456
#define XB_SPIN_CAP (1u << 22)
__device__ __forceinline__ unsigned xb_ld(unsigned* p)              { return __hip_atomic_load(p, __ATOMIC_RELAXED, __HIP_MEMORY_SCOPE_AGENT); }
__device__ __forceinline__ unsigned xb_add(unsigned* p, unsigned v) { return __hip_atomic_fetch_add(p, v, __ATOMIC_RELAXED, __HIP_MEMORY_SCOPE_AGENT); }
__device__ __forceinline__ unsigned xb_xcc_id() { return (unsigned)__builtin_amdgcn_s_getreg((3 << 11) | 20) & 0xFu; }
#define XB_SPIN(cond, bar) do { unsigned _sp = 0; while (cond) { __builtin_amdgcn_s_sleep(1); \
    if ((++_sp & 255u) == 0u) { if (xb_ld(&(bar)[XB_TMO])) break; if (_sp > XB_SPIN_CAP) { atomicAdd(&(bar)[XB_TMO], 1u); break; } } } } while (0)
struct XcdBarrier { unsigned* bar; unsigned x; volatile LAS unsigned* st; };
__device__ __forceinline__ XcdBarrier xcd_barrier_post(unsigned* bar, volatile LAS unsigned* st) {
    XcdBarrier b; b.bar = bar; b.x = xb_xcc_id(); b.st = st;
    if (threadIdx.x == 0) (void)xb_add(&bar[XB_XCNT(b.x)], 1u);
    return b;
}
__device__ __forceinline__ void xcd_barrier_complete(unsigned* bar, unsigned x, unsigned& nloc, unsigned& nx) {
    const unsigned G = gridDim.x * gridDim.y * gridDim.z;
    unsigned sum, cnt, mine, sp = 0u;
    for (;;) {
        sum = 0u; cnt = 0u; mine = 0u;
#pragma unroll
        for (unsigned j = 0; j < 16; ++j) { const unsigned c = xb_ld(&bar[XB_XCNT(j)]); sum += c; cnt += (c > 0u) ? 1u : 0u; mine = (j == x) ? c : mine; }
        if (sum == G) break;
        __builtin_amdgcn_s_sleep(1);
        if ((++sp & 255u) == 0u) { if (xb_ld(&bar[XB_TMO])) break; if (sp > XB_SPIN_CAP) { atomicAdd(&bar[XB_TMO], 1u); break; } }
    }
    nloc = mine > 0u ? mine : 1u; nx = cnt > 0u ? cnt : 1u;
}
__device__ __forceinline__ void xcd_barrier(const XcdBarrier& b) {
    asm volatile("s_waitcnt vmcnt(0)" ::: "memory");
    __syncthreads();
    if (threadIdx.x == 0) {
        unsigned* bar = b.bar;
        __builtin_amdgcn_s_waitcnt(0);
        unsigned nloc = b.st[0], nx = b.st[1];
        if (nloc == 0u) { xcd_barrier_complete(bar, b.x, nloc, nx); b.st[0] = nloc; b.st[1] = nx; }
        const unsigned old = xb_add(&bar[XB_XSUB(b.x)], 1u);
        const unsigned gen = old / nloc;
        if (old + 1u == (gen + 1u) * nloc) {
            __builtin_amdgcn_fence(__ATOMIC_RELEASE, "agent");
            asm volatile("s_waitcnt vmcnt(0)" ::: "memory");
            const unsigned og = xb_add(&bar[XB_TOP], 1u);
            const unsigned tg = og / nx;
            if (og + 1u == (tg + 1u) * nx) xb_add(&bar[XB_TOPGEN], 1u);
            else XB_SPIN(xb_ld(&bar[XB_TOPGEN]) == tg, bar);
            __builtin_amdgcn_fence(__ATOMIC_ACQUIRE, "agent");
            xb_add(&bar[XB_XGEN(b.x)], 1u);
            asm volatile("s_waitcnt vmcnt(0)" ::: "memory");
        } else {
            XB_SPIN(xb_ld(&bar[XB_XGEN(b.x)]) == gen, bar);
            __builtin_amdgcn_fence(__ATOMIC_ACQUIRE, "agent");
            asm volatile("s_waitcnt vmcnt(0)" ::: "memory");
        }
    }
    __syncthreads();
}

namespace pg8 {
#define PG8_LAS __attribute__((address_space(3)))
typedef unsigned short bf16_t;
typedef short bf16x8 __attribute__((ext_vector_type(8)));
typedef float f32x4 __attribute__((ext_vector_type(4)));
typedef unsigned u32x4 __attribute__((ext_vector_type(4)));
constexpr int BM = 256, BK = 64, HALF = 128, HTB = HALF * BK * 2  , STAGE_BYTES = 8 * HTB, NXCD = 8, WGM = 8;

__host__ __device__ __forceinline__ int lds_byte(int r, int c) { const int st = (r >> 4) * 2 + (c >> 5), rr = r & 15, cc = c & 31, ob = rr * 64 + cc * 2; return st * 1024 + (ob ^ (((ob >> 9) & 1) << 5)); }
__host__ __device__ __forceinline__ void stage_rc(int b, int& R, int& C) { const int st = b / 1024, sb = b % 1024, swz = sb ^ (((sb >> 9) & 1) << 5); R = (st >> 1) * 16 + swz / 64; C = (st & 1) * 32 + (swz % 64) / 2; }
__host__ __device__ __forceinline__ int perm32(int rho) { const int n = rho >> 4, i = rho & 15; return 8 * (i >> 2) + 4 * n + (i & 3); }

struct Unit { int pm, pn, sw; };
struct Gemm { const bf16_t* A; const bf16_t* Bt; int M, N, K; };

struct StaticOrder {
    int nM, nN, nwg, G, c;
    __host__ __device__ void init(int M, int N, int G_, int c_) { nM = M / BM; nN = N / BM; nwg = nM * nN; G = G_; c = c_; }
    __host__ __device__ bool next(int i, Unit& u) const {
        const long L = (long)i * G + c; if (L >= nwg) return false;
        int wgid = (int)L; { const int q = nwg / NXCD, r = nwg % NXCD, xcd = wgid % NXCD, off = wgid / NXCD; wgid = (xcd < r ? xcd * (q + 1) : r * (q + 1) + (xcd - r) * q) + off; }
        const int nig = WGM * nN, gid = wgid / nig, fm = gid * WGM, gsz = (nM - fm) < WGM ? (nM - fm) : WGM;
        u.pm = fm + ((wgid % nig) % gsz); u.pn = (wgid % nig) / gsz; u.sw = 0; return true;
    }
    __device__ __forceinline__ void a_ready(const Unit&) const {}
    __device__ __forceinline__ void done(const Unit&) const {}
};

struct ProjOrder : StaticOrder {
    __device__ bool next(int i, Unit& u) const { if (!StaticOrder::next(i, u)) return false; u.sw = (u.pn >= 44) ? 1 : 0; return true; }
};
typedef float f32x2 __attribute__((ext_vector_type(2)));
typedef __bf16 bf16x2_t __attribute__((ext_vector_type(2)));
__device__ __forceinline__ unsigned cvt_pk_bf16(float lo, float hi) { f32x2 v = {lo, hi}; bf16x2_t b = __builtin_convertvector(v, bf16x2_t); return __builtin_bit_cast(unsigned, b); }
__device__ __forceinline__ float bflo(unsigned w) { return __uint_as_float(w << 16); }
__device__ __forceinline__ float bfhi(unsigned w) { return __uint_as_float(w & 0xffff0000u); }
struct EpiF32 {
    static constexpr bool PERM = false, AFTER_DRAIN = false;
    float* C; int ldc;
    __device__ __forceinline__ void operator()(const f32x4 (&acc)[2][2][4][2], const Unit& u, int wr, int wc, int fr, int fq) const {
        const int row0 = u.pm * BM + wr * 64 + fr, col0 = u.pn * BM + wc * 32 + 4 * fq;
#pragma unroll
        for (int ai = 0; ai < 2; ++ai)
#pragma unroll
            for (int m = 0; m < 4; ++m) { float* rowp = C + (size_t)(row0 + ai * HALF + m * 16) * ldc + col0;
#pragma unroll
                for (int bj = 0; bj < 2; ++bj)
#pragma unroll
                    for (int n = 0; n < 2; ++n) *(f32x4*)(rowp + bj * HALF + n * 16) = acc[ai][bj][m][n]; }
    }
};
struct EpiRelu2 {
    static constexpr bool PERM = true, AFTER_DRAIN = false;
    bf16_t* O; int ldc;
    __device__ __forceinline__ void operator()(const f32x4 (&acc)[2][2][4][2], const Unit& u, int wr, int wc, int fr, int fq) const {
        const int row0 = u.pm * BM + wr * 64 + fr, col0 = u.pn * BM + wc * 32 + 8 * fq;
#pragma unroll
        for (int ai = 0; ai < 2; ++ai)
#pragma unroll
            for (int m = 0; m < 4; ++m) { bf16_t* rowp = O + (size_t)(row0 + ai * HALF + m * 16) * ldc + col0;
#pragma unroll
                for (int bj = 0; bj < 2; ++bj) { f32x4 v0 = acc[ai][bj][m][0], v1 = acc[ai][bj][m][1];
                    v0 = __builtin_elementwise_max(v0, (f32x4){0.f, 0.f, 0.f, 0.f}); v1 = __builtin_elementwise_max(v1, (f32x4){0.f, 0.f, 0.f, 0.f}); v0 = v0 * v0; v1 = v1 * v1;
                    u32x4 w; w.x = cvt_pk_bf16(v0[0], v0[1]); w.y = cvt_pk_bf16(v0[2], v0[3]); w.z = cvt_pk_bf16(v1[0], v1[1]); w.w = cvt_pk_bf16(v1[2], v1[3]);
                    *(u32x4*)(rowp + bj * HALF) = w; } }
    }
};
struct EpiGateA {
    static constexpr bool PERM = true, AFTER_DRAIN = false;
    float* TMP; const bf16_t* GA; int ldc;
    __device__ __forceinline__ void operator()(const f32x4 (&acc)[2][2][4][2], const Unit& u, int wr, int wc, int fr, int fq) const {
        const int row0 = u.pm * BM + wr * 64 + fr, col0 = u.pn * BM + wc * 32 + 8 * fq;
#pragma unroll
        for (int ai = 0; ai < 2; ++ai)
#pragma unroll
            for (int m = 0; m < 4; ++m) { const size_t ro = (size_t)(row0 + ai * HALF + m * 16) * ldc + col0;
#pragma unroll
                for (int bj = 0; bj < 2; ++bj) { const u32x4 g = *(const u32x4*)(GA + ro + bj * HALF); const f32x4 v0 = acc[ai][bj][m][0], v1 = acc[ai][bj][m][1];
                    const f32x4 o0 = {v0[0] * bflo(g.x), v0[1] * bfhi(g.x), v0[2] * bflo(g.y), v0[3] * bfhi(g.y)}, o1 = {v1[0] * bflo(g.z), v1[1] * bfhi(g.z), v1[2] * bflo(g.w), v1[3] * bfhi(g.w)};
                    *(f32x4*)(TMP + ro + bj * HALF) = o0; *(f32x4*)(TMP + ro + bj * HALF + 4) = o1; } }
    }
};
struct EpiGateB {
    static constexpr bool PERM = true, AFTER_DRAIN = false;
    const float* TMP; const bf16_t* GB; bf16_t* MIX; int ldc;
    __device__ __forceinline__ void operator()(const f32x4 (&acc)[2][2][4][2], const Unit& u, int wr, int wc, int fr, int fq) const {
        const int row0 = u.pm * BM + wr * 64 + fr, col0 = u.pn * BM + wc * 32 + 8 * fq;
#pragma unroll
        for (int ai = 0; ai < 2; ++ai)
#pragma unroll
            for (int m = 0; m < 4; ++m) { const size_t ro = (size_t)(row0 + ai * HALF + m * 16) * ldc + col0;
#pragma unroll
                for (int bj = 0; bj < 2; ++bj) { const u32x4 g = *(const u32x4*)(GB + ro + bj * HALF); const f32x4 t0 = *(const f32x4*)(TMP + ro + bj * HALF), t1 = *(const f32x4*)(TMP + ro + bj * HALF + 4);
                    const f32x4 v0 = acc[ai][bj][m][0], v1 = acc[ai][bj][m][1];
                    u32x4 w; w.x = cvt_pk_bf16(t0[0] + v0[0] * bflo(g.x), t0[1] + v0[1] * bfhi(g.x)); w.y = cvt_pk_bf16(t0[2] + v0[2] * bflo(g.y), t0[3] + v0[3] * bfhi(g.y));
                    w.z = cvt_pk_bf16(t1[0] + v1[0] * bflo(g.z), t1[1] + v1[1] * bfhi(g.z)); w.w = cvt_pk_bf16(t1[2] + v1[2] * bflo(g.w), t1[3] + v1[3] * bfhi(g.w));
                    *(u32x4*)(MIX + ro + bj * HALF) = w; } }
    }
};
struct EpiProj {
    static constexpr bool PERM = true, AFTER_DRAIN = false;
    bf16_t *QA, *RA, *QB, *KB, *GA, *GB, *KAT, *VAT, *VBT;
    __device__ __forceinline__ void operator()(const f32x4 (&acc)[2][2][4][2], const Unit& u, int wr, int wc, int fr, int fq) const {
        const int wt = u.pn; bf16_t* base; int ldc = 2048, t0; float sc = 1.f; int act = 0;
        if (wt < 4) { base = QA; ldc = 1024; t0 = 0; sc = 0.0625f; }
        else if (wt < 12) { base = RA; t0 = 4; act = 1; }
        else if (wt < 20) { base = QB; t0 = 12; sc = 0.08838834764831845f; }
        else if (wt < 28) { base = KB; t0 = 20; }
        else if (wt < 36) { base = GA; t0 = 28; act = 2; }
        else if (wt < 44) { base = GB; t0 = 36; act = 2; }
        else if (wt < 48) { base = KAT; t0 = 44; ldc = 8192; }
        else if (wt < 56) { base = VAT; t0 = 48; ldc = 8192; }
        else { base = VBT; t0 = 56; ldc = 8192; }
        const int rt = u.sw ? (wt - t0) : u.pm, ct = u.sw ? u.pm : (wt - t0);
        const int row0 = rt * BM + wr * 64 + fr, col0 = ct * BM + wc * 32 + 8 * fq;
#pragma unroll
        for (int ai = 0; ai < 2; ++ai)
#pragma unroll
            for (int m = 0; m < 4; ++m) { bf16_t* rowp = base + (size_t)(row0 + ai * HALF + m * 16) * ldc + col0;
#pragma unroll
                for (int bj = 0; bj < 2; ++bj) { float v[8];
#pragma unroll
                    for (int j = 0; j < 4; ++j) { v[j] = acc[ai][bj][m][0][j] * sc; v[4 + j] = acc[ai][bj][m][1][j] * sc; }
                    if (act) {
#pragma unroll
                        for (int j = 0; j < 8; ++j) { const float s = __builtin_amdgcn_rcpf(1.f + __expf(-v[j])); v[j] = (act == 1) ? v[j] * s : s; } }
                    u32x4 w; w.x = cvt_pk_bf16(v[0], v[1]); w.y = cvt_pk_bf16(v[2], v[3]); w.z = cvt_pk_bf16(v[4], v[5]); w.w = cvt_pk_bf16(v[6], v[7]);
                    *(u32x4*)(rowp + bj * HALF) = w; } }
    }
};

template <class Epi, class Sched, bool ALIGN_EPI = false, bool SP2 = false>
__device__ __forceinline__ void gemm_phase(PG8_LAS unsigned char* lds, const Gemm g, const Sched& S, const Epi& E) {
    int tid_ = threadIdx.x; asm volatile("" : "+v"(tid_));
    const int tid = tid_, wid = __builtin_amdgcn_readfirstlane(tid >> 6), lane = tid & 63, wr = wid >> 2, wc = wid & 3, fr = lane & 15, fq = lane >> 4;
    const int K = g.K, nt = K / BK;
    unsigned voffA[2], voffB[2];
#pragma unroll
    for (int i = 0; i < 2; ++i) { int R, C; stage_rc(tid * 16 + i * 8192, R, C); const int Rb = Epi::PERM ? ((R & ~31) + perm32(R & 31)) : R;
        voffA[i] = (unsigned)(R * K + C) * 2u; voffB[i] = (unsigned)(Rb * K + C) * 2u; }
    const size_t kstep = (size_t)(BK * 2);
    const size_t hstep = (size_t)HALF * K * 2;
    const size_t tstep = 2 * hstep;
    const unsigned ldsw = (unsigned)wid * 1024u;
    const int aoff = lds_byte(wr * 64 + fr, fq * 8), boff = lds_byte(wc * 32 + fr, fq * 8);
#define PG8_SA(b, h) (((b) * 2 + (h)) * HTB)
#define PG8_SB(b, h) ((4 + (b) * 2 + (h)) * HTB)
#define PG8_STAGE(bufoff, gbase, voff) do { _Pragma("unroll") for (int _i = 0; _i < 2; ++_i) \
        __builtin_amdgcn_global_load_lds((const unsigned*)((const char*)(gbase) + (voff)[_i]), (PG8_LAS unsigned*)(lds + (bufoff) + ldsw + _i * 8192), 16, 0, 0); } while (0)
#define PG8_LDA(dst, b, h) do { _Pragma("unroll") for (int m = 0; m < 4; ++m) _Pragma("unroll") for (int k = 0; k < 2; ++k) dst[m][k] = *(const PG8_LAS bf16x8*)(lds + PG8_SA(b, h) + aoff + m * 2048 + k * 1024); } while (0)
#define PG8_LDB(dst, b, h) do { _Pragma("unroll") for (int n = 0; n < 2; ++n) _Pragma("unroll") for (int k = 0; k < 2; ++k) dst[n][k] = *(const PG8_LAS bf16x8*)(lds + PG8_SB(b, h) + boff + n * 2048 + k * 1024); } while (0)
#define PG8_MMA(ai, bj, At, Bt) do { __builtin_amdgcn_s_setprio(1); _Pragma("unroll") for (int m = 0; m < 4; ++m) _Pragma("unroll") for (int n = 0; n < 2; ++n) _Pragma("unroll") for (int k = 0; k < 2; ++k) \
        acc[ai][bj][m][n] = __builtin_amdgcn_mfma_f32_16x16x32_bf16(Bt[n][k], At[m][k], acc[ai][bj][m][n], 0, 0, 0); __builtin_amdgcn_s_setprio(0); } while (0)
#define PG8_WAIT_V(n) asm volatile("s_waitcnt vmcnt(" #n ")" ::: "memory")
#define PG8_WAIT_L(n) asm volatile("s_waitcnt lgkmcnt(" #n ")" ::: "memory")
#define PG8_BAR __builtin_amdgcn_s_barrier()
#define PG8_SCHED __builtin_amdgcn_sched_barrier(0)
    Unit cur, nxt; int ui = 0;
    if (!S.next(0, cur)) return;
    f32x4 acc[2][2][4][2];
#pragma unroll
    for (int a = 0; a < 2; ++a)
#pragma unroll
        for (int b = 0; b < 2; ++b)
#pragma unroll
            for (int m = 0; m < 4; ++m)
#pragma unroll
                for (int n = 0; n < 2; ++n) acc[a][b][m][n] = (f32x4){0.f, 0.f, 0.f, 0.f};
    bf16x8 At[4][2], B0[2][2], B1[2][2];
    const char* cA = cur.sw ? (const char*)g.Bt + (size_t)cur.pn * tstep : (const char*)g.A + (size_t)cur.pm * tstep; const char* cB = cur.sw ? (const char*)g.A + (size_t)cur.pm * tstep : (const char*)g.Bt + (size_t)cur.pn * tstep;
    S.a_ready(cur);
    if constexpr (SP2) {
        PG8_STAGE(PG8_SB(0, 0), cB, voffB); PG8_STAGE(PG8_SB(0, 1), cB + hstep, voffB); PG8_STAGE(PG8_SA(0, 0), cA, voffA); PG8_STAGE(PG8_SA(0, 1), cA + hstep, voffA);
        if (wr == 1) PG8_BAR;
        PG8_WAIT_V(2); PG8_BAR;
        PG8_STAGE(PG8_SB(1, 0), cB + kstep, voffB); PG8_STAGE(PG8_SA(1, 0), cA + kstep, voffA); PG8_STAGE(PG8_SB(1, 1), cB + hstep + kstep, voffB);
        PG8_WAIT_V(6); PG8_BAR;
    } else {
        PG8_STAGE(PG8_SB(0, 0), cB, voffB); PG8_STAGE(PG8_SA(0, 0), cA, voffA); PG8_STAGE(PG8_SB(0, 1), cB + hstep, voffB); PG8_STAGE(PG8_SA(0, 1), cA + hstep, voffA);
        if (wr == 1) PG8_BAR;
        PG8_WAIT_V(4); PG8_BAR;
        PG8_STAGE(PG8_SB(1, 0), cB + kstep, voffB); PG8_STAGE(PG8_SA(1, 0), cA + kstep, voffA); PG8_STAGE(PG8_SB(1, 1), cB + hstep + kstep, voffB);
        PG8_WAIT_V(6); PG8_BAR;
    }
    for (;;) {
        const bool has_next = S.next(ui + 1, nxt);
        const char* nA = has_next ? (nxt.sw ? (const char*)g.Bt + (size_t)nxt.pn * tstep : (const char*)g.A + (size_t)nxt.pm * tstep) : cA; const char* nB = has_next ? (nxt.sw ? (const char*)g.A + (size_t)nxt.pm * tstep : (const char*)g.Bt + (size_t)nxt.pn * tstep) : cB;
        for (int t = 0; t < nt; t += 2) {
            const bool last = (t == nt - 2);
            const char* a1 = cA + (size_t)(t + 1) * kstep;
            const char* a2 = last ? nA : cA + (size_t)(t + 2) * kstep; const char* b2 = last ? nB : cB + (size_t)(t + 2) * kstep;
            const char* a3 = a2 + kstep; const char* b3 = b2 + kstep;
            if (last && has_next) S.a_ready(nxt);
            if constexpr (SP2) {
            PG8_LDB(B0, 0, 0); PG8_LDB(B1, 0, 1); PG8_SCHED; PG8_LDA(At, 0, 0); PG8_STAGE(PG8_SA(1, 1), a1 + hstep, voffA);
            PG8_WAIT_V(8); PG8_WAIT_L(0); PG8_BAR; PG8_MMA(0, 0, At, B0); PG8_MMA(0, 1, At, B1); PG8_BAR; PG8_SCHED;
            PG8_LDA(At, 0, 1); PG8_STAGE(PG8_SB(0, 0), b2, voffB); PG8_STAGE(PG8_SB(0, 1), b2 + hstep, voffB); PG8_STAGE(PG8_SA(0, 0), a2, voffA);
            PG8_WAIT_V(8); PG8_WAIT_L(0); PG8_BAR; PG8_MMA(1, 0, At, B0); PG8_MMA(1, 1, At, B1); PG8_BAR; PG8_SCHED;
            PG8_LDB(B0, 1, 0); PG8_LDB(B1, 1, 1); PG8_SCHED; PG8_LDA(At, 1, 0); PG8_STAGE(PG8_SA(0, 1), a2 + hstep, voffA);
            PG8_WAIT_V(8); PG8_WAIT_L(0); PG8_BAR; PG8_MMA(0, 0, At, B0); PG8_MMA(0, 1, At, B1); PG8_BAR; PG8_SCHED;
            PG8_LDA(At, 1, 1); PG8_STAGE(PG8_SB(1, 0), b3, voffB); PG8_STAGE(PG8_SB(1, 1), b3 + hstep, voffB); PG8_STAGE(PG8_SA(1, 0), a3, voffA);
            PG8_WAIT_V(8); PG8_WAIT_L(0); PG8_BAR; PG8_MMA(1, 0, At, B0); PG8_MMA(1, 1, At, B1); PG8_BAR; PG8_SCHED;
            } else {
            PG8_LDB(B0, 0, 0); PG8_SCHED; PG8_LDA(At, 0, 0); PG8_STAGE(PG8_SA(1, 1), a1 + hstep, voffA);
            PG8_WAIT_L(8); PG8_BAR; PG8_WAIT_L(0); PG8_MMA(0, 0, At, B0); PG8_BAR; PG8_SCHED;
            PG8_LDB(B1, 0, 1); PG8_STAGE(PG8_SB(0, 0), b2, voffB);
            PG8_BAR; PG8_WAIT_L(0); PG8_MMA(0, 1, At, B1); PG8_BAR;
            PG8_LDA(At, 0, 1); PG8_STAGE(PG8_SA(0, 0), a2, voffA);
            PG8_BAR; PG8_WAIT_L(0); PG8_MMA(1, 0, At, B0); PG8_BAR; PG8_SCHED;
            PG8_STAGE(PG8_SB(0, 1), b2 + hstep, voffB);
            PG8_WAIT_V(6); PG8_BAR; PG8_MMA(1, 1, At, B1); PG8_BAR;
            PG8_LDB(B0, 1, 0); PG8_SCHED; PG8_LDA(At, 1, 0); PG8_STAGE(PG8_SA(0, 1), a2 + hstep, voffA);
            PG8_WAIT_L(8); PG8_BAR; PG8_WAIT_L(0); PG8_MMA(0, 0, At, B0); PG8_BAR; PG8_SCHED;
            PG8_LDB(B1, 1, 1); PG8_STAGE(PG8_SB(1, 0), b3, voffB);
            PG8_BAR; PG8_WAIT_L(0); PG8_MMA(0, 1, At, B1); PG8_BAR;
            PG8_LDA(At, 1, 1); PG8_STAGE(PG8_SA(1, 0), a3, voffA);
            PG8_BAR; PG8_WAIT_L(0); PG8_MMA(1, 0, At, B0); PG8_BAR; PG8_SCHED;
            PG8_STAGE(PG8_SB(1, 1), b3 + hstep, voffB);
            PG8_WAIT_V(6); PG8_BAR; PG8_MMA(1, 1, At, B1); PG8_BAR;
            }
        }
        if constexpr (ALIGN_EPI) { if (wr == 0) PG8_BAR; }
        if constexpr (!Epi::AFTER_DRAIN) { E(acc, cur, wr, wc, fr, fq); S.done(cur); }
        if (!has_next) break;
#pragma unroll
        for (int a = 0; a < 2; ++a)
#pragma unroll
            for (int b = 0; b < 2; ++b)
#pragma unroll
                for (int m = 0; m < 4; ++m)
#pragma unroll
                    for (int n = 0; n < 2; ++n) acc[a][b][m][n] = (f32x4){0.f, 0.f, 0.f, 0.f};
        cur = nxt; cA = nA; cB = nB; ++ui;
        if constexpr (ALIGN_EPI) { if (wr == 1) PG8_BAR; }
    }
    PG8_WAIT_V(0);
    if constexpr (!ALIGN_EPI) { if (wr == 0) PG8_BAR; }
    PG8_BAR;
    if constexpr (Epi::AFTER_DRAIN) { E.fused(acc, cur, wr, wc, fr, fq, lds, wid, lane); S.done(cur); }
#undef PG8_SA
#undef PG8_SB
#undef PG8_STAGE
#undef PG8_LDA
#undef PG8_LDB
#undef PG8_MMA
#undef PG8_WAIT_V
#undef PG8_WAIT_L
#undef PG8_BAR
#undef PG8_SCHED
}
}

struct Frame {
    LAS unsigned char* lds;
    int tid, lane, wave, G, bx;
    const float *x, *c, *w_ada, *b_ada, *ng, *w_in, *w_gu, *b_gate, *gn, *w_go, *w_so, *w_out, *w_ff1, *w_ff2;
    float* out; unsigned char* ws;
};
#define WSP(T, off) ((T*)(F.ws + (off)))

template <class Epi>
__device__ __forceinline__ void gold_gemm(Frame& F, const bf16* A, int lda, const float* W, int ldw, int Mrows, int N, int K, const Epi& epi) {
    const int gw = F.bx * NWAVES + F.wave, ngw = F.G * NWAVES, lane = F.lane, r = lane & 31, h = lane >> 5;
    const int tm = Mrows / 64, tn = (N + 63) / 64;
    for (int u = gw; u < tm * tn; u += ngw) {
        const int m0 = (u / tn) * 64, n0 = (u % tn) * 64;
        f32x16 acc[2][2];
#pragma unroll
        for (int i = 0; i < 2; ++i)
#pragma unroll
            for (int j = 0; j < 2; ++j)
#pragma unroll
                for (int e = 0; e < 16; ++e) acc[i][j][e] = 0.f;
        const int nc0 = (n0 + r < N) ? n0 + r : N - 1, nc1 = (n0 + 32 + r < N) ? n0 + 32 + r : N - 1;
        const bf16* a0p = A + (size_t)(m0 + r) * lda + 8 * h; const bf16* a1p = A + (size_t)(m0 + 32 + r) * lda + 8 * h;
        for (int k0 = 0; k0 < K; k0 += 16) {
            const bf16x8 a0 = *(const bf16x8*)(a0p + k0), a1 = *(const bf16x8*)(a1p + k0);
            bf16x8 b0, b1;
#pragma unroll
            for (int j = 0; j < 8; ++j) { const float* wr = W + (size_t)(k0 + 8 * h + j) * ldw; b0[j] = (short)f2bf(wr[nc0]); b1[j] = (short)f2bf(wr[nc1]); }
            acc[0][0] = __builtin_amdgcn_mfma_f32_32x32x16_bf16(a0, b0, acc[0][0], 0, 0, 0);
            acc[0][1] = __builtin_amdgcn_mfma_f32_32x32x16_bf16(a0, b1, acc[0][1], 0, 0, 0);
            acc[1][0] = __builtin_amdgcn_mfma_f32_32x32x16_bf16(a1, b0, acc[1][0], 0, 0, 0);
            acc[1][1] = __builtin_amdgcn_mfma_f32_32x32x16_bf16(a1, b1, acc[1][1], 0, 0, 0);
        }
#pragma unroll
        for (int i = 0; i < 2; ++i)
#pragma unroll
            for (int j = 0; j < 2; ++j)
#pragma unroll
                for (int e = 0; e < 16; ++e) { const int row = m0 + 32 * i + (e & 3) + 8 * (e >> 2) + 4 * h, col = n0 + 32 * j + r; if (col < N) epi(row, col, acc[i][j][e]); }
    }
}
struct GEpiProj { bf16 *QA, *RA, *QB, *KB, *GA, *GB, *KAT, *VAT, *VBT;
    __device__ __forceinline__ void operator()(int row, int col, float v) const {
        if (col < C_KA) QA[(size_t)row * GK + col] = (bf16)f2bf(v * 0.0625f);
        else if (col < C_VA) KAT[(size_t)(col - C_KA) * MTOK + row] = (bf16)f2bf(v);
        else if (col < C_RA) VAT[(size_t)(col - C_VA) * MTOK + row] = (bf16)f2bf(v);
        else if (col < C_AL) RA[(size_t)row * GV + col - C_RA] = (bf16)f2bf(v * sigmoidf_(v));
        else if (col < C_QB) { }
        else if (col < C_KB) QB[(size_t)row * DM + col - C_QB] = (bf16)f2bf(v * 0.08838834764831845f);
        else if (col < C_VB) KB[(size_t)row * DM + col - C_KB] = (bf16)f2bf(v);
        else if (col < C_GA) VBT[(size_t)(col - C_VB) * MTOK + row] = (bf16)f2bf(v);
        else if (col < C_GB) GA[(size_t)row * DM + col - C_GA] = (bf16)f2bf(sigmoidf_(v));
        else GB[(size_t)row * DM + col - C_GB] = (bf16)f2bf(sigmoidf_(v));
    } };
struct GEpiGateA { float* TMP; const bf16* GA; __device__ __forceinline__ void operator()(int row, int col, float v) const { const size_t i = (size_t)row * DM + col; TMP[i] = v * bf2f(GA[i]); } };
struct GEpiGateB { const float* TMP; const bf16* GB; bf16* MIX; __device__ __forceinline__ void operator()(int row, int col, float v) const { const size_t i = (size_t)row * DM + col; MIX[i] = (bf16)f2bf(TMP[i] + v * bf2f(GB[i])); } };
struct GEpiF32 { float* C; int ldc; __device__ __forceinline__ void operator()(int row, int col, float v) const { C[(size_t)row * ldc + col] = v; } };
struct GEpiRelu2 { bf16* O; int ldc; __device__ __forceinline__ void operator()(int row, int col, float v) const { const float t = fmaxf(v, 0.f); O[(size_t)row * ldc + col] = (bf16)f2bf(t * t); } };

__device__ __forceinline__ void p0_mod(Frame& F) {
    LAS float* cact = (LAS float*)F.lds;
    LAS float* red = (LAS float*)(F.lds + 32768);
    for (int i = F.tid; i < NB * DM; i += NTHR) { const float v = F.c[i]; cact[i] = v * sigmoidf_(v); }
    __syncthreads();
    float* MOD = WSP(float, WS_MOD);
    for (int u = F.bx; u < DEPTH * 48; u += F.G) {
        const int l = u / 48, n0 = (u % 48) * 256;
        const float* W = F.w_ada + (size_t)l * DM * (6 * DM) + n0 + 4 * F.lane;
        f32x4 acc[4];
#pragma unroll
        for (int b = 0; b < 4; ++b) acc[b] = (f32x4){0.f, 0.f, 0.f, 0.f};
        const int kb = F.wave * 256;
#pragma unroll 8
        for (int k = 0; k < 256; ++k) {
            const f32x4 wv = *(const f32x4*)(W + (size_t)(kb + k) * (6 * DM));
#pragma unroll
            for (int b = 0; b < 4; ++b) acc[b] += cact[b * DM + kb + k] * wv;
        }
#pragma unroll
        for (int b = 0; b < 4; ++b) *(LAS f32x4*)(red + (F.wave * 4 + b) * 256 + 4 * F.lane) = acc[b];
        __syncthreads();
#pragma unroll
        for (int i = 0; i < 2; ++i) {
            const int o = F.tid * 2 + i, b = o >> 8, col = o & 255; float s = F.b_ada[(size_t)l * 6 * DM + n0 + col];
#pragma unroll
            for (int w = 0; w < 8; ++w) s += red[(w * 4 + b) * 256 + col];
            MOD[(size_t)(l * NB + b) * (6 * DM) + n0 + col] = s;
        }
        __syncthreads();
    }
}

__device__ __forceinline__ int win_src_col(int d) {
    if (d < 1024) return C_QA + d;
    if (d < 3072) return C_RA + d - 1024;
    if (d < 5120) return C_QB + d - 3072;
    if (d < 7168) return C_KB + d - 5120;
    if (d < 9216) return C_GA + d - 7168;
    if (d < 11264) return C_GB + d - 9216;
    if (d < 12288) return C_KA + d - 11264;
    if (d < 14336) return C_VA + d - 12288;
    return C_VB + d - 14336;
}
__device__ __forceinline__ void tr_item(const float* src, int lds_, bf16* dst, int ldd, LAS float* scr, int lane) {
#pragma unroll 8
    for (int i = 0; i < 32; ++i) { const int kk = 2 * i + (lane >> 5); scr[kk * 33 + (lane & 31)] = src[(size_t)kk * lds_ + (lane & 31)]; }
    LDS_WAIT(); asm volatile("" ::: "memory");
    const int c = lane & 7;
#pragma unroll
    for (int j = 0; j < 4; ++j) { const int n = (lane >> 3) + 8 * j; const LAS float* s = scr + (8 * c) * 33 + n;
        v4u o; o.x = pk2(s[0 * 33], s[1 * 33]); o.y = pk2(s[2 * 33], s[3 * 33]); o.z = pk2(s[4 * 33], s[5 * 33]); o.w = pk2(s[6 * 33], s[7 * 33]);
        *(v4u*)(dst + (size_t)n * ldd + 8 * c) = o; }
    LDS_WAIT(); asm volatile("" ::: "memory");
}
__device__ __forceinline__ void p0_transposes(Frame& F) {
    LAS float* scr = (LAS float*)(F.lds + F.wave * 16384);
    const int gw = F.bx * NWAVES + F.wave, ngw = F.G * NWAVES, lane = F.lane;
    constexpr int I_IN = 32 * 512, I_SQ = 32 * 64, I_F1 = 32 * 256, I_F2 = 128 * 64, I_L = I_IN + 3 * I_SQ + I_F1 + I_F2;
    for (int it = gw; it < DEPTH * I_L; it += ngw) {
        const int l = it / I_L; int r = it % I_L; unsigned char* wl = F.ws + WS_W + (size_t)l * WL_STRIDE;
        if (r < I_IN) { const int kb = r / 512, d0 = (r % 512) * 32;
            tr_item(F.w_in + (size_t)l * DM * INCOLS + (size_t)(kb * 64) * INCOLS + win_src_col(d0), INCOLS, (bf16*)(wl + WL_IN) + (size_t)d0 * DM + kb * 64, DM, scr, lane); continue; }
        r -= I_IN;
        if (r < I_SQ) { const int kb = r / 64, n0 = (r % 64) * 32;
            tr_item(F.w_go + (size_t)l * DM * DM + (size_t)(kb * 64) * DM + n0, DM, (bf16*)(wl + WL_GO) + (size_t)n0 * DM + kb * 64, DM, scr, lane); continue; }
        r -= I_SQ;
        if (r < I_SQ) { const int kb = r / 64, n0 = (r % 64) * 32;
            tr_item(F.w_so + (size_t)l * DM * DM + (size_t)(kb * 64) * DM + n0, DM, (bf16*)(wl + WL_SO) + (size_t)n0 * DM + kb * 64, DM, scr, lane); continue; }
        r -= I_SQ;
        if (r < I_SQ) { const int kb = r / 64, n0 = (r % 64) * 32;
            tr_item(F.w_out + (size_t)l * DM * DM + (size_t)(kb * 64) * DM + n0, DM, (bf16*)(wl + WL_OUT) + (size_t)n0 * DM + kb * 64, DM, scr, lane); continue; }
        r -= I_SQ;
        if (r < I_F1) { const int kb = r / 256, n0 = (r % 256) * 32;
            tr_item(F.w_ff1 + (size_t)l * DM * DFF + (size_t)(kb * 64) * DFF + n0, DFF, (bf16*)(wl + WL_FF1) + (size_t)n0 * DM + kb * 64, DM, scr, lane); continue; }
        r -= I_F1;
        { const int kb = r / 64, n0 = (r % 64) * 32;
            tr_item(F.w_ff2 + (size_t)l * DFF * DM + (size_t)(kb * 64) * DM + n0, DM, (bf16*)(wl + WL_FF2) + (size_t)n0 * DFF + kb * 64, DFF, scr, lane); }
    }
}

__device__ __forceinline__ void row_load(const float* p, int lane, f32x4 (&v)[8]) {
#pragma unroll
    for (int j = 0; j < 8; ++j) v[j] = *(const f32x4*)(p + 256 * j + 4 * lane);
}
__device__ __forceinline__ float row_rstd(const f32x4 (&v)[8]) {
    float s = 0.f;
#pragma unroll
    for (int j = 0; j < 8; ++j) s += (v[j].x * v[j].x + v[j].y * v[j].y) + (v[j].z * v[j].z + v[j].w * v[j].w);
    return rsqrtf(wave_sum(s) * (1.f / DM) + EPS);
}
__device__ __forceinline__ void row_emit_h(const f32x4 (&x)[8], const float* ng, const float* sc, const float* sh, bf16* hrow, int lane) {
    const float rs = row_rstd(x);
#pragma unroll
    for (int j = 0; j < 8; ++j) {
        const int o = 256 * j + 4 * lane;
        const f32x4 g = *(const f32x4*)(ng + o), s = *(const f32x4*)(sc + o), t = *(const f32x4*)(sh + o);
        const f32x4 hv = x[j] * rs * g * (1.f + s) + t;
        v2u w; w.x = pk2(hv.x, hv.y); w.y = pk2(hv.z, hv.w);
        *(v2u*)(hrow + o) = w;
    }
}
template <int MODE> __device__ __forceinline__ void row_phase(Frame& F, int l) {
    const int gw = F.bx * NWAVES + F.wave, ngw = F.G * NWAVES, lane = F.lane;
    const float* MOD = WSP(float, WS_MOD); bf16* H = WSP(bf16, WS_H); const float* M2 = WSP(float, WS_M2);
    for (int m = gw; m < MTOK; m += ngw) {
        const int b = m / SEQ; const float* modp = MOD + (size_t)(l * NB + b) * (6 * DM);
        f32x4 x[8];
        if (MODE == 0) {
            row_load(F.x + (size_t)m * DM, lane, x);
            row_emit_h(x, F.ng + (size_t)(l * 4 + 0) * DM, modp + DM, modp, H + (size_t)m * DM, lane);
        } else {
            const float* xs = ((MODE == 1 && l == 0) ? F.x : F.out) + (size_t)m * DM;
            row_load(xs, lane, x);
            f32x4 y[8]; row_load(M2 + (size_t)m * DM, lane, y);
            const float rs = row_rstd(y);
            const float* g = modp + (MODE == 1 ? 2 * DM : 5 * DM); const float* ngy = F.ng + (size_t)(l * 4 + (MODE == 1 ? 1 : 3)) * DM;
#pragma unroll
            for (int j = 0; j < 8; ++j) { const int o = 256 * j + 4 * lane; const f32x4 gv = *(const f32x4*)(g + o), nv = *(const f32x4*)(ngy + o);
                x[j] = x[j] + gv * (y[j] * rs * nv); *(f32x4*)(F.out + (size_t)m * DM + o) = x[j]; }
            if (MODE == 1) row_emit_h(x, F.ng + (size_t)(l * 4 + 2) * DM, modp + 4 * DM, modp + 3 * DM, H + (size_t)m * DM, lane);
            else if (l + 1 < DEPTH) { const float* modn = MOD + (size_t)((l + 1) * NB + b) * (6 * DM);
                row_emit_h(x, F.ng + (size_t)((l + 1) * 4 + 0) * DM, modn + DM, modn, H + (size_t)m * DM, lane); }
        }
    }
}

__device__ __forceinline__ void gcalc(Frame& F, int l) {
    LAS float* al = (LAS float*)F.lds;
    const bf16* H = WSP(bf16, WS_H); bf16* GT = WSP(bf16, WS_GT); float* DEC = WSP(float, WS_DEC);
    for (int u = F.bx; u < 256; u += F.G) {
        const int cc = u >> 1, kd = (u & 1) * 512 + F.tid;
        {
            const int t = F.tid >> 3, r0 = (F.tid & 7) * 2; float a0 = 0.f, a1 = 0.f;
            const bf16* hp = H + (size_t)(cc * 64 + t) * DM; const float* wp = F.w_in + (size_t)l * DM * INCOLS + C_AL + r0;
            for (int k0 = 0; k0 < DM; k0 += 8) {
                const v4u hv = *(const v4u*)(hp + k0);
                const float hh[8] = {bf2f(hv.x & 0xffffu), bf2f(hv.x >> 16), bf2f(hv.y & 0xffffu), bf2f(hv.y >> 16), bf2f(hv.z & 0xffffu), bf2f(hv.z >> 16), bf2f(hv.w & 0xffffu), bf2f(hv.w >> 16)};
#pragma unroll
                for (int i = 0; i < 8; ++i) { const f32x2 w = *(const f32x2*)(wp + (size_t)(k0 + i) * INCOLS); a0 += hh[i] * bf2f(f2bf(w.x)); a1 += hh[i] * bf2f(f2bf(w.y)); }
            }
            al[t * 16 + r0] = a0; al[t * 16 + r0 + 1] = a1;
        }
        __syncthreads();
        float wg[16];
#pragma unroll
        for (int r = 0; r < 16; ++r) wg[r] = F.w_gu[(size_t)(l * RANK + r) * GK + kd];
        const float bg = F.b_gate[(size_t)l * GK + kd];
        float la[64];
#pragma unroll
        for (int t = 0; t < 64; ++t) { float s = bg;
#pragma unroll
            for (int r = 0; r < 16; ++r) s += al[t * 16 + r] * wg[r];
            la[t] = logsig(s) * 0.0625f; }
        float suf = 0.f;
#pragma unroll
        for (int t8 = 7; t8 >= 0; --t8) { float g[8];
#pragma unroll
            for (int i = 7; i >= 0; --i) { g[i] = __expf(suf); suf += la[t8 * 8 + i]; }
            v4u w; w.x = pk2(g[0], g[1]); w.y = pk2(g[2], g[3]); w.z = pk2(g[4], g[5]); w.w = pk2(g[6], g[7]);
            *(v4u*)(GT + (size_t)kd * MTOK + cc * 64 + t8 * 8) = w; }
        DEC[(size_t)cc * GK + kd] = __expf(suf);
        __syncthreads();
    }
}

__device__ __forceinline__ void gla_gold(Frame& F) {
    LAS float* S = (LAS float*)F.lds;
    LAS float* vv = (LAS float*)(F.lds + 33792);
    LAS bf16* kp = (LAS bf16*)(F.lds + 33792 + 8320);
    LAS bf16* qq = (LAS bf16*)(F.lds + 33792 + 8320 + 33792);
    const bf16* KAT = WSP(bf16, WS_KAT); const bf16* GT = WSP(bf16, WS_GT); const bf16* VAT = WSP(bf16, WS_VAT); const bf16* QA = WSP(bf16, WS_QA);
    const float* DEC = WSP(float, WS_DEC); bf16* OG = WSP(bf16, WS_OG);
    for (int u = F.bx; u < 256; u += F.G) {
        const int b = u >> 6, hg = (u >> 4) & 3, vs = u & 15;
        for (int i = F.tid; i < 256 * 33; i += NTHR) S[i] = 0.f;
        __syncthreads();
        for (int c = 0; c < 32; ++c) {
            const int T0 = b * SEQ + c * 64, cc = b * 32 + c;
            { const int k = F.tid >> 1, t0 = (F.tid & 1) * 32; const size_t go = (size_t)(hg * GDK + k) * MTOK + T0 + t0;
#pragma unroll
              for (int i = 0; i < 32; ++i) kp[k * 66 + t0 + i] = (bf16)f2bf(bf2f(KAT[go + i]) * bf2f(GT[go + i])); }
            { const int v = F.tid >> 4, t0 = (F.tid & 15) * 4; const size_t go = (size_t)(hg * GDV + vs * 32 + v) * MTOK + T0 + t0;
#pragma unroll
              for (int i = 0; i < 4; ++i) vv[v * 65 + t0 + i] = bf2f(VAT[go + i]); }
            { const int t = F.tid >> 3, k0 = (F.tid & 7) * 32; const size_t go = (size_t)(T0 + t) * GK + hg * GDK + k0;
#pragma unroll
              for (int i = 0; i < 32; ++i) qq[t * 258 + k0 + i] = QA[go + i]; }
            __syncthreads();
#pragma unroll 1
            for (int i = 0; i < 16; ++i) { const int e = F.tid + 512 * i, k = e >> 5, v = e & 31;
                float acc = S[k * 33 + v] * DEC[(size_t)cc * GK + hg * GDK + k];
                for (int t = 0; t < 64; ++t) acc += bf2f(kp[k * 66 + t]) * vv[v * 65 + t];
                S[k * 33 + v] = acc; }
            __syncthreads();
#pragma unroll 1
            for (int i = 0; i < 4; ++i) { const int e = F.tid + 512 * i, t = e >> 5, v = e & 31; float acc = 0.f;
                for (int k = 0; k < 256; ++k) acc += bf2f(qq[t * 258 + k]) * S[k * 33 + v];
                OG[(size_t)(T0 + t) * GV + hg * GDV + vs * 32 + v] = (bf16)f2bf(acc); }
            __syncthreads();
        }
    }
}

__device__ __forceinline__ void sb_gold(Frame& F) {
    const int gw = F.bx * NWAVES + F.wave, ngw = F.G * NWAVES, lane = F.lane;
    const bf16* QB = WSP(bf16, WS_QB); const bf16* KB = WSP(bf16, WS_KB); const bf16* VBT = WSP(bf16, WS_VBT); bf16* SBO = WSP(bf16, WS_SBO);
    for (int rid = gw; rid < NB * SH * SEQ; rid += ngw) {
        const int t = rid % SEQ, bh = rid / SEQ, b = bh / SH, h = bh % SH;
        const unsigned qw = *(const unsigned*)(QB + (size_t)(b * SEQ + t) * DM + h * SDH + 2 * lane);
        const float q0 = bf2f(qw & 0xffffu), q1 = bf2f(qw >> 16);
        float o0 = 0.f, o1 = 0.f, P = 1.f;
        const bf16* v0p = VBT + (size_t)(h * SDH + 2 * lane) * MTOK + b * SEQ; const bf16* v1p = v0p + MTOK;
        for (int s = t - 1; s >= 0; --s) {
            if (P == 0.f) break;
            const unsigned kw = *(const unsigned*)(KB + (size_t)(b * SEQ + s) * DM + h * SDH + 2 * lane);
            float z = wave_sum(q0 * bf2f(kw & 0xffffu) + q1 * bf2f(kw >> 16));
            z = fminf(fmaxf(z, -80.f), 80.f);
            const float e = __expf(-z), beta = __builtin_amdgcn_rcpf(1.f + e), w = beta * P;
            P *= e * beta;
            o0 += w * bf2f(v0p[s]); o1 += w * bf2f(v1p[s]);
        }
        *(unsigned*)(SBO + (size_t)(b * SEQ + t) * DM + h * SDH + 2 * lane) = pk2(o0, o1);
    }
}

__device__ __forceinline__ void gla_gate(Frame& F, int l) {
    const int gw = F.bx * NWAVES + F.wave, ngw = F.G * NWAVES, lane = F.lane;
    const bf16* OG = WSP(bf16, WS_OG); const bf16* RA = WSP(bf16, WS_RA); bf16* GIN = WSP(bf16, WS_GIN);
    for (int m = gw; m < MTOK; m += ngw) {
#pragma unroll
        for (int hg = 0; hg < 4; ++hg) {
            const size_t o = (size_t)m * GV + hg * GDV + 8 * lane;
            const v4u ov = *(const v4u*)(OG + o), rv = *(const v4u*)(RA + o);
            float x[8]; x[0] = bf2f(ov.x & 0xffffu); x[1] = bf2f(ov.x >> 16); x[2] = bf2f(ov.y & 0xffffu); x[3] = bf2f(ov.y >> 16);
            x[4] = bf2f(ov.z & 0xffffu); x[5] = bf2f(ov.z >> 16); x[6] = bf2f(ov.w & 0xffffu); x[7] = bf2f(ov.w >> 16);
            float r[8]; r[0] = bf2f(rv.x & 0xffffu); r[1] = bf2f(rv.x >> 16); r[2] = bf2f(rv.y & 0xffffu); r[3] = bf2f(rv.y >> 16);
            r[4] = bf2f(rv.z & 0xffffu); r[5] = bf2f(rv.z >> 16); r[6] = bf2f(rv.w & 0xffffu); r[7] = bf2f(rv.w >> 16);
            float s = 0.f;
#pragma unroll
            for (int i = 0; i < 8; ++i) s += x[i] * x[i];
            const float rs = rsqrtf(wave_sum(s) * (1.f / GDV) + EPS);
            const float* gp = F.gn + (size_t)(l * GH + hg) * GDV + 8 * lane;
            const f32x4 g0 = *(const f32x4*)gp, g1 = *(const f32x4*)(gp + 4);
            const float gg[8] = {g0.x, g0.y, g0.z, g0.w, g1.x, g1.y, g1.z, g1.w};
            float y[8];
#pragma unroll
            for (int i = 0; i < 8; ++i) y[i] = x[i] * rs * gg[i] * r[i];
            v4u w; w.x = pk2(y[0], y[1]); w.y = pk2(y[2], y[3]); w.z = pk2(y[4], y[5]); w.w = pk2(y[6], y[7]);
            *(v4u*)(GIN + o) = w;
        }
    }
}

constexpr int NPHASE = 2 + 9 * DEPTH;
struct Args { const float* in[14]; float* out; unsigned char* ws; int ph_lo, ph_hi, use_bar, pad; };
__global__ void __launch_bounds__(NTHR, 2) fwd(Args args) {
    extern __shared__ __attribute__((aligned(16))) unsigned char lds[];
    Frame F;
    F.lds = (LAS unsigned char*)lds; F.tid = threadIdx.x; F.lane = F.tid & 63; F.wave = __builtin_amdgcn_readfirstlane(F.tid >> 6); F.G = gridDim.x; F.bx = blockIdx.x;
    F.x = args.in[0]; F.c = args.in[1]; F.w_ada = args.in[2]; F.b_ada = args.in[3]; F.ng = args.in[4]; F.w_in = args.in[5]; F.w_gu = args.in[6]; F.b_gate = args.in[7];
    F.gn = args.in[8]; F.w_go = args.in[9]; F.w_so = args.in[10]; F.w_out = args.in[11]; F.w_ff1 = args.in[12]; F.w_ff2 = args.in[13]; F.out = args.out; F.ws = args.ws;
    volatile LAS unsigned* MISC = (volatile LAS unsigned*)(F.lds + MISC_OFF);
    for (int u = F.tid; u < (LDS_BYTES - LDSCTL_OFF) / 4; u += NTHR) ((LAS unsigned*)(F.lds + LDSCTL_OFF))[u] = 0u;
    __syncthreads();
    XcdBarrier bar; bar.bar = (unsigned*)(F.ws + WS_CTL) + CW_BAR; bar.x = 0; bar.st = nullptr;
    if (args.use_bar) bar = xcd_barrier_post((unsigned*)(F.ws + WS_CTL) + CW_BAR, MISC + 8);
    const int lo = args.ph_lo, hi = args.ph_hi;
#define IN(k) (lo <= (k) && (k) < hi)
#define SEAM(k) do { if (IN(k) && IN((k) + 1)) xcd_barrier(bar); } while (0)

    if (IN(0)) { p0_mod(F); if (FAST_GEMM) p0_transposes(F); } SEAM(0);
    if (IN(1)) { row_phase<0>(F, 0); } SEAM(1);
    for (int l = 0; l < DEPTH; ++l) {
        const int pb = 2 + 9 * l;
        { int t_ = threadIdx.x; asm volatile("" : "+v"(t_)); F.tid = t_; F.lane = t_ & 63; }
        if (IN(pb + 0)) {
            gcalc(F, l);
            if (FAST_GEMM & 1) {
                __syncthreads();
                pg8::Gemm g{WSP(bf16, WS_H), (const bf16*)(F.ws + WS_W + (size_t)l * WL_STRIDE + WL_IN), MTOK, 16384, DM}; pg8::ProjOrder S; S.init(MTOK, 16384, F.G, F.bx);
                pg8::EpiProj E{WSP(bf16, WS_QA), WSP(bf16, WS_RA), WSP(bf16, WS_QB), WSP(bf16, WS_KB), WSP(bf16, WS_GA), WSP(bf16, WS_GB), WSP(bf16, WS_KAT), WSP(bf16, WS_VAT), WSP(bf16, WS_VBT)};
                pg8::gemm_phase<pg8::EpiProj, pg8::ProjOrder, true, true>(F.lds, g, S, E);
            } else {
            GEpiProj E{WSP(bf16, WS_QA), WSP(bf16, WS_RA), WSP(bf16, WS_QB), WSP(bf16, WS_KB), WSP(bf16, WS_GA), WSP(bf16, WS_GB), WSP(bf16, WS_KAT), WSP(bf16, WS_VAT), WSP(bf16, WS_VBT)};
            gold_gemm(F, WSP(bf16, WS_H), DM, F.w_in + (size_t)l * DM * INCOLS, INCOLS, MTOK, INCOLS, DM, E);
            }
        } SEAM(pb + 0);
        if (IN(pb + 1)) {
            gla_gold(F);
            __syncthreads();
            sb_gold(F);
        } SEAM(pb + 1);
        if (IN(pb + 2)) { gla_gate(F, l); } SEAM(pb + 2);
        if (IN(pb + 3)) {
            if (FAST_GEMM & 2) {
                const unsigned char* wl = F.ws + WS_W + (size_t)l * WL_STRIDE;
                { pg8::Gemm g{WSP(bf16, WS_GIN), (const bf16*)(wl + WL_GO), MTOK, DM, GV}; pg8::StaticOrder S; S.init(MTOK, DM, F.G, F.bx);
                  pg8::EpiGateA E{WSP(float, WS_TMP), WSP(bf16, WS_GA), DM}; pg8::gemm_phase<pg8::EpiGateA, pg8::StaticOrder, false, true>(F.lds, g, S, E); }
                { pg8::Gemm g{WSP(bf16, WS_SBO), (const bf16*)(wl + WL_SO), MTOK, DM, DM}; pg8::StaticOrder S; S.init(MTOK, DM, F.G, F.bx);
                  pg8::EpiGateB E{WSP(float, WS_TMP), WSP(bf16, WS_GB), WSP(bf16, WS_MIX), DM}; pg8::gemm_phase<pg8::EpiGateB, pg8::StaticOrder, false, true>(F.lds, g, S, E); }
            } else {
            GEpiGateA EA{WSP(float, WS_TMP), WSP(bf16, WS_GA)};
            gold_gemm(F, WSP(bf16, WS_GIN), GV, F.w_go + (size_t)l * GV * DM, DM, MTOK, DM, GV, EA);
            GEpiGateB EB{WSP(float, WS_TMP), WSP(bf16, WS_GB), WSP(bf16, WS_MIX)};
            gold_gemm(F, WSP(bf16, WS_SBO), DM, F.w_so + (size_t)l * DM * DM, DM, MTOK, DM, DM, EB);
            }
        } SEAM(pb + 3);
        if (IN(pb + 4)) {
            if (FAST_GEMM & 4) {
                pg8::Gemm g{WSP(bf16, WS_MIX), (const bf16*)(F.ws + WS_W + (size_t)l * WL_STRIDE + WL_OUT), MTOK, DM, DM}; pg8::StaticOrder S; S.init(MTOK, DM, F.G, F.bx);
                pg8::EpiF32 E{WSP(float, WS_M2), DM}; pg8::gemm_phase<pg8::EpiF32, pg8::StaticOrder, false, true>(F.lds, g, S, E);
            } else {
            GEpiF32 E{WSP(float, WS_M2), DM};
            gold_gemm(F, WSP(bf16, WS_MIX), DM, F.w_out + (size_t)l * DM * DM, DM, MTOK, DM, DM, E);
            }
        } SEAM(pb + 4);
        if (IN(pb + 5)) { row_phase<1>(F, l); } SEAM(pb + 5);
        if (IN(pb + 6)) {
            if (FAST_GEMM & 8) {
                pg8::Gemm g{WSP(bf16, WS_H), (const bf16*)(F.ws + WS_W + (size_t)l * WL_STRIDE + WL_FF1), MTOK, DFF, DM}; pg8::StaticOrder S; S.init(MTOK, DFF, F.G, F.bx);
                pg8::EpiRelu2 E{WSP(bf16, WS_F1), DFF}; pg8::gemm_phase<pg8::EpiRelu2, pg8::StaticOrder, true, true>(F.lds, g, S, E);
            } else {
            GEpiRelu2 E{WSP(bf16, WS_F1), DFF};
            gold_gemm(F, WSP(bf16, WS_H), DM, F.w_ff1 + (size_t)l * DM * DFF, DFF, MTOK, DFF, DM, E);
            }
        } SEAM(pb + 6);
        if (IN(pb + 7)) {
            if (FAST_GEMM & 16) {
                pg8::Gemm g{WSP(bf16, WS_F1), (const bf16*)(F.ws + WS_W + (size_t)l * WL_STRIDE + WL_FF2), MTOK, DM, DFF}; pg8::StaticOrder S; S.init(MTOK, DM, F.G, F.bx);
                pg8::EpiF32 E{WSP(float, WS_M2), DM}; pg8::gemm_phase<pg8::EpiF32, pg8::StaticOrder, false, true>(F.lds, g, S, E);
            } else {
            GEpiF32 E{WSP(float, WS_M2), DM};
            gold_gemm(F, WSP(bf16, WS_F1), DFF, F.w_ff2 + (size_t)l * DFF * DM, DM, MTOK, DM, DFF, E);
            }
        } SEAM(pb + 7);
        if (IN(pb + 8)) { row_phase<2>(F, l); } SEAM(pb + 8);
    }
#undef IN
#undef SEAM
}

extern "C" void kernel_launch(void* const* d_in, const int* in_sizes, int n_in, void* d_out, int out_size, void* d_ws, size_t ws_size, hipStream_t stream) {
    static int grid = 0;
    if (grid == 0) {
        if (n_in != 14 || out_size != MTOK * DM || ws_size < WS_END) { fprintf(stderr, "kernel_launch: unexpected shapes (n_in %d out %d ws %zu)\n", n_in, out_size, ws_size); grid = -1; return; }
        int dev = 0, cus = 0, per_cu = 0;
        if (hipGetDevice(&dev) != hipSuccess || hipDeviceGetAttribute(&cus, hipDeviceAttributeMultiprocessorCount, dev) != hipSuccess) { grid = -1; return; }
        if (hipFuncSetAttribute((const void*)fwd, hipFuncAttributeMaxDynamicSharedMemorySize, LDS_BYTES) != hipSuccess) { fprintf(stderr, "kernel_launch: hipFuncSetAttribute failed\n"); grid = -1; return; }
        if (hipOccupancyMaxActiveBlocksPerMultiprocessor(&per_cu, (const void*)fwd, NTHR, LDS_BYTES) != hipSuccess || per_cu < 1) fprintf(stderr, "kernel_launch: occupancy query says %d\n", per_cu);
        (void)hipGetLastError();
        grid = cus;
    }
    if (grid < 0) return;
    (void)hipMemsetAsync((char*)d_ws + WS_CTL, 0, CTL_ZERO_BYTES, stream);
    Args a{};
    for (int i = 0; i < 14; ++i) a.in[i] = (const float*)d_in[i];
    a.out = (float*)d_out; a.ws = (unsigned char*)d_ws;
#if N_LAUNCHES == 1
    a.ph_lo = 0; a.ph_hi = NPHASE; a.use_bar = 1;
    hipLaunchKernelGGL(fwd, dim3(grid), dim3(NTHR), LDS_BYTES, stream, a);
#else
    for (int p = 0; p < NPHASE; ++p) { a.ph_lo = p; a.ph_hi = p + 1; a.use_bar = 0; hipLaunchKernelGGL(fwd, dim3(grid), dim3(NTHR), LDS_BYTES, stream, a); }
#endif
}
```

```cpp
#include <hip/hip_runtime.h>
#include <cstdio>
#include <cstdint>

#ifndef N_LAUNCHES
#define N_LAUNCHES 1
#endif
#ifndef FAST_GEMM
#define FAST_GEMM 31
#endif
#ifndef FAST_GLA
#define FAST_GLA 1
#endif
#ifndef FAST_SB
#define FAST_SB 1
#endif

#define GAS __attribute__((address_space(1)))
#define LAS __attribute__((address_space(3)))
typedef unsigned short bf16;
typedef float f32x4 __attribute__((ext_vector_type(4)));
typedef float f32x2 __attribute__((ext_vector_type(2)));
typedef float f32x16 __attribute__((ext_vector_type(16)));
typedef short bf16x8 __attribute__((ext_vector_type(8)));
typedef unsigned v4u __attribute__((ext_vector_type(4)));
typedef unsigned v2u __attribute__((ext_vector_type(2)));
typedef GAS unsigned gu32;
#define RLX_AGENT __ATOMIC_RELAXED, __HIP_MEMORY_SCOPE_AGENT
#define LDS_WAIT() asm volatile("s_waitcnt lgkmcnt(0)" ::: "memory")
#define VM_WAIT() asm volatile("s_waitcnt vmcnt(0)" ::: "memory")

constexpr int DM = 2048, NB = 4, SEQ = 2048, DEPTH = 4, MTOK = NB * SEQ;
constexpr int GH = 4, GDK = 256, GDV = 512, GK = 1024, GV = 2048, RANK = 16, SH = 16, SDH = 128, DFF = 8192, INCOLS = 16400;
constexpr int C_QA = 0, C_KA = 1024, C_VA = 2048, C_RA = 4096, C_AL = 6144, C_QB = 6160, C_KB = 8208, C_VB = 10256, C_GA = 12304, C_GB = 14352;
constexpr float EPS = 1e-6f;
constexpr int NWAVES = 8, NTHR = 512;

constexpr size_t MiB = 1u << 20;
constexpr size_t WS_CTL = 0, CTL_ZERO_BYTES = 1 * MiB;
constexpr size_t WS_MOD = 1 * MiB;
constexpr size_t WS_WA = 2 * MiB;
constexpr size_t WS_DEC = 3 * MiB;
constexpr size_t WS_W = 4 * MiB;
constexpr size_t WL_IN = 0, WL_GO = 64 * MiB, WL_SO = 72 * MiB, WL_OUT = 80 * MiB, WL_FF1 = 88 * MiB, WL_FF2 = 120 * MiB, WL_STRIDE = 152 * MiB;
constexpr size_t WS_H = 612 * MiB;
constexpr size_t WS_PROJ = 644 * MiB;
constexpr size_t WS_QA = WS_PROJ, WS_RA = WS_QA + 16 * MiB, WS_QB = WS_RA + 32 * MiB, WS_KB = WS_QB + 32 * MiB, WS_GA = WS_KB + 32 * MiB, WS_GB = WS_GA + 32 * MiB,
                 WS_KAT = WS_GB + 32 * MiB, WS_VAT = WS_KAT + 16 * MiB, WS_VBT = WS_VAT + 32 * MiB;
constexpr size_t WS_F1 = WS_PROJ;
constexpr size_t WS_GT = 900 * MiB;
constexpr size_t WS_OG = 916 * MiB, WS_GIN = 948 * MiB, WS_SBO = 980 * MiB;
constexpr size_t WS_TMP = 1012 * MiB;
constexpr size_t WS_MIX = 1076 * MiB;
constexpr size_t WS_M2 = 1108 * MiB;
constexpr size_t WS_END = 1172 * MiB;
static_assert(WS_VBT + 32 * MiB == 900 * MiB, "proj map");

constexpr int CW_TMO = 0, CW_CODE = 1, CW_BAR = 4096;
constexpr int RING_BYTES = 131072, LDSCTL_OFF = RING_BYTES, MISC_OFF = LDSCTL_OFF + 320, LDS_BYTES = 147456;

__device__ __forceinline__ float bf2f(unsigned b) { return __uint_as_float(b << 16); }
__device__ __forceinline__ unsigned f2bf(float f) { unsigned u = __float_as_uint(f); return (u + 0x7fffu + ((u >> 16) & 1u)) >> 16; }
__device__ __forceinline__ unsigned pk2(float lo, float hi) { return f2bf(lo) | (f2bf(hi) << 16); }
__device__ __forceinline__ float wave_sum(float v) {
#pragma unroll
    for (int o = 1; o < 64; o <<= 1) v += __shfl_xor(v, o);
    return v;
}
__device__ __forceinline__ float sigmoidf_(float v) { return __builtin_amdgcn_rcpf(1.f + __expf(-v)); }
__device__ __forceinline__ float logsig(float x) { return fminf(x, 0.f) - __logf(1.f + __expf(-fabsf(x))); }

#define XB_TMO      128
#define XB_XCNT(j)  (256  + 64 * (j))
#define XB_XSUB(j)  (1280 + 64 * (j))
#define XB_XGEN(j)  (2304 + 64 * (j))
#define XB_TOP      3328
#define XB_TOPGEN   3392
#define XCD_BAR_WORDS 3456
#define XB_SPIN_CAP (1u << 22)
__device__ __forceinline__ unsigned xb_ld(unsigned* p)              { return __hip_atomic_load(p, __ATOMIC_RELAXED, __HIP_MEMORY_SCOPE_AGENT); }
__device__ __forceinline__ unsigned xb_add(unsigned* p, unsigned v) { return __hip_atomic_fetch_add(p, v, __ATOMIC_RELAXED, __HIP_MEMORY_SCOPE_AGENT); }
__device__ __forceinline__ unsigned xb_xcc_id() { return (unsigned)__builtin_amdgcn_s_getreg((3 << 11) | 20) & 0xFu; }
#define XB_SPIN(cond, bar) do { unsigned _sp = 0; while (cond) { __builtin_amdgcn_s_sleep(1); \
    if ((++_sp & 255u) == 0u) { if (xb_ld(&(bar)[XB_TMO])) break; if (_sp > XB_SPIN_CAP) { atomicAdd(&(bar)[XB_TMO], 1u); break; } } } } while (0)
struct XcdBarrier { unsigned* bar; unsigned x; volatile LAS unsigned* st; };
__device__ __forceinline__ XcdBarrier xcd_barrier_post(unsigned* bar, volatile LAS unsigned* st) {
    XcdBarrier b; b.bar = bar; b.x = xb_xcc_id(); b.st = st;
    if (threadIdx.x == 0) (void)xb_add(&bar[XB_XCNT(b.x)], 1u);
    return b;
}
__device__ __forceinline__ void xcd_barrier_complete(unsigned* bar, unsigned x, unsigned& nloc, unsigned& nx) {
    const unsigned G = gridDim.x * gridDim.y * gridDim.z;
    unsigned sum, cnt, mine, sp = 0u;
    for (;;) {
        sum = 0u; cnt = 0u; mine = 0u;
#pragma unroll
        for (unsigned j = 0; j < 16; ++j) { const unsigned c = xb_ld(&bar[XB_XCNT(j)]); sum += c; cnt += (c > 0u) ? 1u : 0u; mine = (j == x) ? c : mine; }
        if (sum == G) break;
        __builtin_amdgcn_s_sleep(1);
        if ((++sp & 255u) == 0u) { if (xb_ld(&bar[XB_TMO])) break; if (sp > XB_SPIN_CAP) { atomicAdd(&bar[XB_TMO], 1u); break; } }
    }
    nloc = mine > 0u ? mine : 1u; nx = cnt > 0u ? cnt : 1u;
}
__device__ __forceinline__ void xcd_barrier(const XcdBarrier& b) {
    asm volatile("s_waitcnt vmcnt(0)" ::: "memory");
    __syncthreads();
    if (threadIdx.x == 0) {
        unsigned* bar = b.bar;
        __builtin_amdgcn_s_waitcnt(0);
        unsigned nloc = b.st[0], nx = b.st[1];
        if (nloc == 0u) { xcd_barrier_complete(bar, b.x, nloc, nx); b.st[0] = nloc; b.st[1] = nx; }
        const unsigned old = xb_add(&bar[XB_XSUB(b.x)], 1u);
        const unsigned gen = old / nloc;
        if (old + 1u == (gen + 1u) * nloc) {
            __builtin_amdgcn_fence(__ATOMIC_RELEASE, "agent");
            asm volatile("s_waitcnt vmcnt(0)" ::: "memory");
            const unsigned og = xb_add(&bar[XB_TOP], 1u);
            const unsigned tg = og / nx;
            if (og + 1u == (tg + 1u) * nx) xb_add(&bar[XB_TOPGEN], 1u);
            else XB_SPIN(xb_ld(&bar[XB_TOPGEN]) == tg, bar);
            __builtin_amdgcn_fence(__ATOMIC_ACQUIRE, "agent");
            xb_add(&bar[XB_XGEN(b.x)], 1u);
            asm volatile("s_waitcnt vmcnt(0)" ::: "memory");
        } else {
            XB_SPIN(xb_ld(&bar[XB_XGEN(b.x)]) == gen, bar);
            __builtin_amdgcn_fence(__ATOMIC_ACQUIRE, "agent");
            asm volatile("s_waitcnt vmcnt(0)" ::: "memory");
        }
    }
    __syncthreads();
}

namespace pg8 {
#define PG8_LAS __attribute__((address_space(3)))
typedef unsigned short bf16_t;
typedef short bf16x8 __attribute__((ext_vector_type(8)));
typedef float f32x4 __attribute__((ext_vector_type(4)));
typedef unsigned u32x4 __attribute__((ext_vector_type(4)));
constexpr int BM = 256, BK = 64, HALF = 128, HTB = HALF * BK * 2  , STAGE_BYTES = 8 * HTB, NXCD = 8, WGM = 8;

__host__ __device__ __forceinline__ int lds_byte(int r, int c) { const int st = (r >> 4) * 2 + (c >> 5), rr = r & 15, cc = c & 31, ob = rr * 64 + cc * 2; return st * 1024 + (ob ^ (((ob >> 9) & 1) << 5)); }
__host__ __device__ __forceinline__ void stage_rc(int b, int& R, int& C) { const int st = b / 1024, sb = b % 1024, swz = sb ^ (((sb >> 9) & 1) << 5); R = (st >> 1) * 16 + swz / 64; C = (st & 1) * 32 + (swz % 64) / 2; }
__host__ __device__ __forceinline__ int perm32(int rho) { const int n = rho >> 4, i = rho & 15; return 8 * (i >> 2) + 4 * n + (i & 3); }

struct Unit { int pm, pn, sw; };
struct Gemm { const bf16_t* A; const bf16_t* Bt; int M, N, K; };

struct StaticOrder {
    int nM, nN, nwg, G, c;
    __host__ __device__ void init(int M, int N, int G_, int c_) { nM = M / BM; nN = N / BM; nwg = nM * nN; G = G_; c = c_; }
    __host__ __device__ bool next(int i, Unit& u) const {
        const long L = (long)i * G + c; if (L >= nwg) return false;
        int wgid = (int)L; { const int q = nwg / NXCD, r = nwg % NXCD, xcd = wgid % NXCD, off = wgid / NXCD; wgid = (xcd < r ? xcd * (q + 1) : r * (q + 1) + (xcd - r) * q) + off; }
        const int nig = WGM * nN, gid = wgid / nig, fm = gid * WGM, gsz = (nM - fm) < WGM ? (nM - fm) : WGM;
        u.pm = fm + ((wgid % nig) % gsz); u.pn = (wgid % nig) / gsz; u.sw = 0; return true;
    }
    __device__ __forceinline__ void a_ready(const Unit&) const {}
    __device__ __forceinline__ void done(const Unit&) const {}
};

struct ProjOrder : StaticOrder {
    __device__ bool next(int i, Unit& u) const { if (!StaticOrder::next(i, u)) return false; u.sw = (u.pn >= 44) ? 1 : 0; return true; }
};
typedef float f32x2 __attribute__((ext_vector_type(2)));
typedef __bf16 bf16x2_t __attribute__((ext_vector_type(2)));
__device__ __forceinline__ unsigned cvt_pk_bf16(float lo, float hi) { f32x2 v = {lo, hi}; bf16x2_t b = __builtin_convertvector(v, bf16x2_t); return __builtin_bit_cast(unsigned, b); }
__device__ __forceinline__ float bflo(unsigned w) { return __uint_as_float(w << 16); }
__device__ __forceinline__ float bfhi(unsigned w) { return __uint_as_float(w & 0xffff0000u); }
struct EpiF32 {
    static constexpr bool PERM = false, AFTER_DRAIN = false;
    float* C; int ldc;
    __device__ __forceinline__ void operator()(const f32x4 (&acc)[2][2][4][2], const Unit& u, int wr, int wc, int fr, int fq) const {
        const int row0 = u.pm * BM + wr * 64 + fr, col0 = u.pn * BM + wc * 32 + 4 * fq;
#pragma unroll
        for (int ai = 0; ai < 2; ++ai)
#pragma unroll
            for (int m = 0; m < 4; ++m) { float* rowp = C + (size_t)(row0 + ai * HALF + m * 16) * ldc + col0;
#pragma unroll
                for (int bj = 0; bj < 2; ++bj)
#pragma unroll
                    for (int n = 0; n < 2; ++n) *(f32x4*)(rowp + bj * HALF + n * 16) = acc[ai][bj][m][n]; }
    }
};
struct EpiRelu2 {
    static constexpr bool PERM = true, AFTER_DRAIN = false;
    bf16_t* O; int ldc;
    __device__ __forceinline__ void operator()(const f32x4 (&acc)[2][2][4][2], const Unit& u, int wr, int wc, int fr, int fq) const {
        const int row0 = u.pm * BM + wr * 64 + fr, col0 = u.pn * BM + wc * 32 + 8 * fq;
#pragma unroll
        for (int ai = 0; ai < 2; ++ai)
#pragma unroll
            for (int m = 0; m < 4; ++m) { bf16_t* rowp = O + (size_t)(row0 + ai * HALF + m * 16) * ldc + col0;
#pragma unroll
                for (int bj = 0; bj < 2; ++bj) { f32x4 v0 = acc[ai][bj][m][0], v1 = acc[ai][bj][m][1];
                    v0 = __builtin_elementwise_max(v0, (f32x4){0.f, 0.f, 0.f, 0.f}); v1 = __builtin_elementwise_max(v1, (f32x4){0.f, 0.f, 0.f, 0.f}); v0 = v0 * v0; v1 = v1 * v1;
                    u32x4 w; w.x = cvt_pk_bf16(v0[0], v0[1]); w.y = cvt_pk_bf16(v0[2], v0[3]); w.z = cvt_pk_bf16(v1[0], v1[1]); w.w = cvt_pk_bf16(v1[2], v1[3]);
                    *(u32x4*)(rowp + bj * HALF) = w; } }
    }
};
struct EpiGateA {
    static constexpr bool PERM = true, AFTER_DRAIN = false;
    float* TMP; const bf16_t* GA; int ldc;
    __device__ __forceinline__ void operator()(const f32x4 (&acc)[2][2][4][2], const Unit& u, int wr, int wc, int fr, int fq) const {
        const int row0 = u.pm * BM + wr * 64 + fr, col0 = u.pn * BM + wc * 32 + 8 * fq;
#pragma unroll
        for (int ai = 0; ai < 2; ++ai)
#pragma unroll
            for (int m = 0; m < 4; ++m) { const size_t ro = (size_t)(row0 + ai * HALF + m * 16) * ldc + col0;
#pragma unroll
                for (int bj = 0; bj < 2; ++bj) { const u32x4 g = *(const u32x4*)(GA + ro + bj * HALF); const f32x4 v0 = acc[ai][bj][m][0], v1 = acc[ai][bj][m][1];
                    const f32x4 o0 = {v0[0] * bflo(g.x), v0[1] * bfhi(g.x), v0[2] * bflo(g.y), v0[3] * bfhi(g.y)}, o1 = {v1[0] * bflo(g.z), v1[1] * bfhi(g.z), v1[2] * bflo(g.w), v1[3] * bfhi(g.w)};
                    *(f32x4*)(TMP + ro + bj * HALF) = o0; *(f32x4*)(TMP + ro + bj * HALF + 4) = o1; } }
    }
};
struct EpiGateB {
    static constexpr bool PERM = true, AFTER_DRAIN = false;
    const float* TMP; const bf16_t* GB; bf16_t* MIX; int ldc;
    __device__ __forceinline__ void operator()(const f32x4 (&acc)[2][2][4][2], const Unit& u, int wr, int wc, int fr, int fq) const {
        const int row0 = u.pm * BM + wr * 64 + fr, col0 = u.pn * BM + wc * 32 + 8 * fq;
#pragma unroll
        for (int ai = 0; ai < 2; ++ai)
#pragma unroll
            for (int m = 0; m < 4; ++m) { const size_t ro = (size_t)(row0 + ai * HALF + m * 16) * ldc + col0;
#pragma unroll
                for (int bj = 0; bj < 2; ++bj) { const u32x4 g = *(const u32x4*)(GB + ro + bj * HALF); const f32x4 t0 = *(const f32x4*)(TMP + ro + bj * HALF), t1 = *(const f32x4*)(TMP + ro + bj * HALF + 4);
                    const f32x4 v0 = acc[ai][bj][m][0], v1 = acc[ai][bj][m][1];
                    u32x4 w; w.x = cvt_pk_bf16(t0[0] + v0[0] * bflo(g.x), t0[1] + v0[1] * bfhi(g.x)); w.y = cvt_pk_bf16(t0[2] + v0[2] * bflo(g.y), t0[3] + v0[3] * bfhi(g.y));
                    w.z = cvt_pk_bf16(t1[0] + v1[0] * bflo(g.z), t1[1] + v1[1] * bfhi(g.z)); w.w = cvt_pk_bf16(t1[2] + v1[2] * bflo(g.w), t1[3] + v1[3] * bfhi(g.w));
                    *(u32x4*)(MIX + ro + bj * HALF) = w; } }
    }
};
struct EpiProj {
    static constexpr bool PERM = true, AFTER_DRAIN = false;
    bf16_t *QA, *RA, *QB, *KB, *GA, *GB, *KAT, *VAT, *VBT;
    __device__ __forceinline__ void operator()(const f32x4 (&acc)[2][2][4][2], const Unit& u, int wr, int wc, int fr, int fq) const {
        const int wt = u.pn; bf16_t* base; int ldc = 2048, t0; float sc = 1.f; int act = 0;
        if (wt < 4) { base = QA; ldc = 1024; t0 = 0; sc = 0.0625f; }
        else if (wt < 12) { base = RA; t0 = 4; act = 1; }
        else if (wt < 20) { base = QB; t0 = 12; sc = 0.08838834764831845f; }
        else if (wt < 28) { base = KB; t0 = 20; }
        else if (wt < 36) { base = GA; t0 = 28; act = 2; }
        else if (wt < 44) { base = GB; t0 = 36; act = 2; }
        else if (wt < 48) { base = KAT; t0 = 44; ldc = 8192; }
        else if (wt < 56) { base = VAT; t0 = 48; ldc = 8192; }
        else { base = VBT; t0 = 56; ldc = 8192; }
        const int rt = u.sw ? (wt - t0) : u.pm, ct = u.sw ? u.pm : (wt - t0);
        const int row0 = rt * BM + wr * 64 + fr, col0 = ct * BM + wc * 32 + 8 * fq;
#pragma unroll
        for (int ai = 0; ai < 2; ++ai)
#pragma unroll
            for (int m = 0; m < 4; ++m) { bf16_t* rowp = base + (size_t)(row0 + ai * HALF + m * 16) * ldc + col0;
#pragma unroll
                for (int bj = 0; bj < 2; ++bj) { float v[8];
#pragma unroll
                    for (int j = 0; j < 4; ++j) { v[j] = acc[ai][bj][m][0][j] * sc; v[4 + j] = acc[ai][bj][m][1][j] * sc; }
                    if (act) {
#pragma unroll
                        for (int j = 0; j < 8; ++j) { const float s = __builtin_amdgcn_rcpf(1.f + __expf(-v[j])); v[j] = (act == 1) ? v[j] * s : s; } }
                    u32x4 w; w.x = cvt_pk_bf16(v[0], v[1]); w.y = cvt_pk_bf16(v[2], v[3]); w.z = cvt_pk_bf16(v[4], v[5]); w.w = cvt_pk_bf16(v[6], v[7]);
                    *(u32x4*)(rowp + bj * HALF) = w; } }
    }
};

template <class Epi, class Sched, bool ALIGN_EPI = false, bool SP2 = false>
__device__ __forceinline__ void gemm_phase(PG8_LAS unsigned char* lds, const Gemm g, const Sched& S, const Epi& E) {
    int tid_ = threadIdx.x; asm volatile("" : "+v"(tid_));
    const int tid = tid_, wid = __builtin_amdgcn_readfirstlane(tid >> 6), lane = tid & 63, wr = wid >> 2, wc = wid & 3, fr = lane & 15, fq = lane >> 4;
    const int K = g.K, nt = K / BK;
    unsigned voffA[2], voffB[2];
#pragma unroll
    for (int i = 0; i < 2; ++i) { int R, C; stage_rc(tid * 16 + i * 8192, R, C); const int Rb = Epi::PERM ? ((R & ~31) + perm32(R & 31)) : R;
        voffA[i] = (unsigned)(R * K + C) * 2u; voffB[i] = (unsigned)(Rb * K + C) * 2u; }
    const size_t kstep = (size_t)(BK * 2);
    const size_t hstep = (size_t)HALF * K * 2;
    const size_t tstep = 2 * hstep;
    const unsigned ldsw = (unsigned)wid * 1024u;
    const int aoff = lds_byte(wr * 64 + fr, fq * 8), boff = lds_byte(wc * 32 + fr, fq * 8);
#define PG8_SA(b, h) (((b) * 2 + (h)) * HTB)
#define PG8_SB(b, h) ((4 + (b) * 2 + (h)) * HTB)
#define PG8_STAGE(bufoff, gbase, voff) do { _Pragma("unroll") for (int _i = 0; _i < 2; ++_i) \
        __builtin_amdgcn_global_load_lds((const unsigned*)((const char*)(gbase) + (voff)[_i]), (PG8_LAS unsigned*)(lds + (bufoff) + ldsw + _i * 8192), 16, 0, 0); } while (0)
#define PG8_LDA(dst, b, h) do { _Pragma("unroll") for (int m = 0; m < 4; ++m) _Pragma("unroll") for (int k = 0; k < 2; ++k) dst[m][k] = *(const PG8_LAS bf16x8*)(lds + PG8_SA(b, h) + aoff + m * 2048 + k * 1024); } while (0)
#define PG8_LDB(dst, b, h) do { _Pragma("unroll") for (int n = 0; n < 2; ++n) _Pragma("unroll") for (int k = 0; k < 2; ++k) dst[n][k] = *(const PG8_LAS bf16x8*)(lds + PG8_SB(b, h) + boff + n * 2048 + k * 1024); } while (0)
#define PG8_MMA(ai, bj, At, Bt) do { __builtin_amdgcn_s_setprio(1); _Pragma("unroll") for (int m = 0; m < 4; ++m) _Pragma("unroll") for (int n = 0; n < 2; ++n) _Pragma("unroll") for (int k = 0; k < 2; ++k) \
        acc[ai][bj][m][n] = __builtin_amdgcn_mfma_f32_16x16x32_bf16(Bt[n][k], At[m][k], acc[ai][bj][m][n], 0, 0, 0); __builtin_amdgcn_s_setprio(0); } while (0)
#define PG8_WAIT_V(n) asm volatile("s_waitcnt vmcnt(" #n ")" ::: "memory")
#define PG8_WAIT_L(n) asm volatile("s_waitcnt lgkmcnt(" #n ")" ::: "memory")
#define PG8_BAR __builtin_amdgcn_s_barrier()
#define PG8_SCHED __builtin_amdgcn_sched_barrier(0)
    Unit cur, nxt; int ui = 0;
    if (!S.next(0, cur)) return;
    f32x4 acc[2][2][4][2];
#pragma unroll
    for (int a = 0; a < 2; ++a)
#pragma unroll
        for (int b = 0; b < 2; ++b)
#pragma unroll
            for (int m = 0; m < 4; ++m)
#pragma unroll
                for (int n = 0; n < 2; ++n) acc[a][b][m][n] = (f32x4){0.f, 0.f, 0.f, 0.f};
    bf16x8 At[4][2], B0[2][2], B1[2][2];
    const char* cA = cur.sw ? (const char*)g.Bt + (size_t)cur.pn * tstep : (const char*)g.A + (size_t)cur.pm * tstep; const char* cB = cur.sw ? (const char*)g.A + (size_t)cur.pm * tstep : (const char*)g.Bt + (size_t)cur.pn * tstep;
    S.a_ready(cur);
    if constexpr (SP2) {
        PG8_STAGE(PG8_SB(0, 0), cB, voffB); PG8_STAGE(PG8_SB(0, 1), cB + hstep, voffB); PG8_STAGE(PG8_SA(0, 0), cA, voffA); PG8_STAGE(PG8_SA(0, 1), cA + hstep, voffA);
        if (wr == 1) PG8_BAR;
        PG8_WAIT_V(2); PG8_BAR;
        PG8_STAGE(PG8_SB(1, 0), cB + kstep, voffB); PG8_STAGE(PG8_SA(1, 0), cA + kstep, voffA); PG8_STAGE(PG8_SB(1, 1), cB + hstep + kstep, voffB);
        PG8_WAIT_V(6); PG8_BAR;
    } else {
        PG8_STAGE(PG8_SB(0, 0), cB, voffB); PG8_STAGE(PG8_SA(0, 0), cA, voffA); PG8_STAGE(PG8_SB(0, 1), cB + hstep, voffB); PG8_STAGE(PG8_SA(0, 1), cA + hstep, voffA);
        if (wr == 1) PG8_BAR;
        PG8_WAIT_V(4); PG8_BAR;
        PG8_STAGE(PG8_SB(1, 0), cB + kstep, voffB); PG8_STAGE(PG8_SA(1, 0), cA + kstep, voffA); PG8_STAGE(PG8_SB(1, 1), cB + hstep + kstep, voffB);
        PG8_WAIT_V(6); PG8_BAR;
    }
    for (;;) {
        const bool has_next = S.next(ui + 1, nxt);
        const char* nA = has_next ? (nxt.sw ? (const char*)g.Bt + (size_t)nxt.pn * tstep : (const char*)g.A + (size_t)nxt.pm * tstep) : cA; const char* nB = has_next ? (nxt.sw ? (const char*)g.A + (size_t)nxt.pm * tstep : (const char*)g.Bt + (size_t)nxt.pn * tstep) : cB;
        for (int t = 0; t < nt; t += 2) {
            const bool last = (t == nt - 2);
            const char* a1 = cA + (size_t)(t + 1) * kstep;
            const char* a2 = last ? nA : cA + (size_t)(t + 2) * kstep; const char* b2 = last ? nB : cB + (size_t)(t + 2) * kstep;
            const char* a3 = a2 + kstep; const char* b3 = b2 + kstep;
            if (last && has_next) S.a_ready(nxt);
            if constexpr (SP2) {
            PG8_LDB(B0, 0, 0); PG8_LDB(B1, 0, 1); PG8_SCHED; PG8_LDA(At, 0, 0); PG8_STAGE(PG8_SA(1, 1), a1 + hstep, voffA);
            PG8_WAIT_V(8); PG8_WAIT_L(0); PG8_BAR; PG8_MMA(0, 0, At, B0); PG8_MMA(0, 1, At, B1); PG8_BAR; PG8_SCHED;
            PG8_LDA(At, 0, 1); PG8_STAGE(PG8_SB(0, 0), b2, voffB); PG8_STAGE(PG8_SB(0, 1), b2 + hstep, voffB); PG8_STAGE(PG8_SA(0, 0), a2, voffA);
            PG8_WAIT_V(8); PG8_WAIT_L(0); PG8_BAR; PG8_MMA(1, 0, At, B0); PG8_MMA(1, 1, At, B1); PG8_BAR; PG8_SCHED;
            PG8_LDB(B0, 1, 0); PG8_LDB(B1, 1, 1); PG8_SCHED; PG8_LDA(At, 1, 0); PG8_STAGE(PG8_SA(0, 1), a2 + hstep, voffA);
            PG8_WAIT_V(8); PG8_WAIT_L(0); PG8_BAR; PG8_MMA(0, 0, At, B0); PG8_MMA(0, 1, At, B1); PG8_BAR; PG8_SCHED;
            PG8_LDA(At, 1, 1); PG8_STAGE(PG8_SB(1, 0), b3, voffB); PG8_STAGE(PG8_SB(1, 1), b3 + hstep, voffB); PG8_STAGE(PG8_SA(1, 0), a3, voffA);
            PG8_WAIT_V(8); PG8_WAIT_L(0); PG8_BAR; PG8_MMA(1, 0, At, B0); PG8_MMA(1, 1, At, B1); PG8_BAR; PG8_SCHED;
            } else {
            PG8_LDB(B0, 0, 0); PG8_SCHED; PG8_LDA(At, 0, 0); PG8_STAGE(PG8_SA(1, 1), a1 + hstep, voffA);
            PG8_WAIT_L(8); PG8_BAR; PG8_WAIT_L(0); PG8_MMA(0, 0, At, B0); PG8_BAR; PG8_SCHED;
            PG8_LDB(B1, 0, 1); PG8_STAGE(PG8_SB(0, 0), b2, voffB);
            PG8_BAR; PG8_WAIT_L(0); PG8_MMA(0, 1, At, B1); PG8_BAR;
            PG8_LDA(At, 0, 1); PG8_STAGE(PG8_SA(0, 0), a2, voffA);
            PG8_BAR; PG8_WAIT_L(0); PG8_MMA(1, 0, At, B0); PG8_BAR; PG8_SCHED;
            PG8_STAGE(PG8_SB(0, 1), b2 + hstep, voffB);
            PG8_WAIT_V(6); PG8_BAR; PG8_MMA(1, 1, At, B1); PG8_BAR;
            PG8_LDB(B0, 1, 0); PG8_SCHED; PG8_LDA(At, 1, 0); PG8_STAGE(PG8_SA(0, 1), a2 + hstep, voffA);
            PG8_WAIT_L(8); PG8_BAR; PG8_WAIT_L(0); PG8_MMA(0, 0, At, B0); PG8_BAR; PG8_SCHED;
            PG8_LDB(B1, 1, 1); PG8_STAGE(PG8_SB(1, 0), b3, voffB);
            PG8_BAR; PG8_WAIT_L(0); PG8_MMA(0, 1, At, B1); PG8_BAR;
            PG8_LDA(At, 1, 1); PG8_STAGE(PG8_SA(1, 0), a3, voffA);
            PG8_BAR; PG8_WAIT_L(0); PG8_MMA(1, 0, At, B0); PG8_BAR; PG8_SCHED;
            PG8_STAGE(PG8_SB(1, 1), b3 + hstep, voffB);
            PG8_WAIT_V(6); PG8_BAR; PG8_MMA(1, 1, At, B1); PG8_BAR;
            }
        }
        if constexpr (ALIGN_EPI) { if (wr == 0) PG8_BAR; }
        if constexpr (!Epi::AFTER_DRAIN) { E(acc, cur, wr, wc, fr, fq); S.done(cur); }
        if (!has_next) break;
#pragma unroll
        for (int a = 0; a < 2; ++a)
#pragma unroll
            for (int b = 0; b < 2; ++b)
#pragma unroll
                for (int m = 0; m < 4; ++m)
#pragma unroll
                    for (int n = 0; n < 2; ++n) acc[a][b][m][n] = (f32x4){0.f, 0.f, 0.f, 0.f};
        cur = nxt; cA = nA; cB = nB; ++ui;
        if constexpr (ALIGN_EPI) { if (wr == 1) PG8_BAR; }
    }
    PG8_WAIT_V(0);
    if constexpr (!ALIGN_EPI) { if (wr == 0) PG8_BAR; }
    PG8_BAR;
    if constexpr (Epi::AFTER_DRAIN) { E.fused(acc, cur, wr, wc, fr, fq, lds, wid, lane); S.done(cur); }
#undef PG8_SA
#undef PG8_SB
#undef PG8_STAGE
#undef PG8_LDA
#undef PG8_LDB
#undef PG8_MMA
#undef PG8_WAIT_V
#undef PG8_WAIT_L
#undef PG8_BAR
#undef PG8_SCHED
}
}

struct Frame {
    LAS unsigned char* lds;
    int tid, lane, wave, G, bx;
    const float *x, *c, *w_ada, *b_ada, *ng, *w_in, *w_gu, *b_gate, *gn, *w_go, *w_so, *w_out, *w_ff1, *w_ff2;
    float* out; unsigned char* ws;
};
#define WSP(T, off) ((T*)(F.ws + (off)))

template <class Epi>
__device__ __forceinline__ void gold_gemm(Frame& F, const bf16* A, int lda, const float* W, int ldw, int Mrows, int N, int K, const Epi& epi) {
    const int gw = F.bx * NWAVES + F.wave, ngw = F.G * NWAVES, lane = F.lane, r = lane & 31, h = lane >> 5;
    const int tm = Mrows / 64, tn = (N + 63) / 64;
    for (int u = gw; u < tm * tn; u += ngw) {
        const int m0 = (u / tn) * 64, n0 = (u % tn) * 64;
        f32x16 acc[2][2];
#pragma unroll
        for (int i = 0; i < 2; ++i)
#pragma unroll
            for (int j = 0; j < 2; ++j)
#pragma unroll
                for (int e = 0; e < 16; ++e) acc[i][j][e] = 0.f;
        const int nc0 = (n0 + r < N) ? n0 + r : N - 1, nc1 = (n0 + 32 + r < N) ? n0 + 32 + r : N - 1;
        const bf16* a0p = A + (size_t)(m0 + r) * lda + 8 * h; const bf16* a1p = A + (size_t)(m0 + 32 + r) * lda + 8 * h;
        for (int k0 = 0; k0 < K; k0 += 16) {
            const bf16x8 a0 = *(const bf16x8*)(a0p + k0), a1 = *(const bf16x8*)(a1p + k0);
            bf16x8 b0, b1;
#pragma unroll
            for (int j = 0; j < 8; ++j) { const float* wr = W + (size_t)(k0 + 8 * h + j) * ldw; b0[j] = (short)f2bf(wr[nc0]); b1[j] = (short)f2bf(wr[nc1]); }
            acc[0][0] = __builtin_amdgcn_mfma_f32_32x32x16_bf16(a0, b0, acc[0][0], 0, 0, 0);
            acc[0][1] = __builtin_amdgcn_mfma_f32_32x32x16_bf16(a0, b1, acc[0][1], 0, 0, 0);
            acc[1][0] = __builtin_amdgcn_mfma_f32_32x32x16_bf16(a1, b0, acc[1][0], 0, 0, 0);
            acc[1][1] = __builtin_amdgcn_mfma_f32_32x32x16_bf16(a1, b1, acc[1][1], 0, 0, 0);
        }
#pragma unroll
        for (int i = 0; i < 2; ++i)
#pragma unroll
            for (int j = 0; j < 2; ++j)
#pragma unroll
                for (int e = 0; e < 16; ++e) { const int row = m0 + 32 * i + (e & 3) + 8 * (e >> 2) + 4 * h, col = n0 + 32 * j + r; if (col < N) epi(row, col, acc[i][j][e]); }
    }
}
struct GEpiProj { bf16 *QA, *RA, *QB, *KB, *GA, *GB, *KAT, *VAT, *VBT;
    __device__ __forceinline__ void operator()(int row, int col, float v) const {
        if (col < C_KA) QA[(size_t)row * GK + col] = (bf16)f2bf(v * 0.0625f);
        else if (col < C_VA) KAT[(size_t)(col - C_KA) * MTOK + row] = (bf16)f2bf(v);
        else if (col < C_RA) VAT[(size_t)(col - C_VA) * MTOK + row] = (bf16)f2bf(v);
        else if (col < C_AL) RA[(size_t)row * GV + col - C_RA] = (bf16)f2bf(v * sigmoidf_(v));
        else if (col < C_QB) { }
        else if (col < C_KB) QB[(size_t)row * DM + col - C_QB] = (bf16)f2bf(v * 0.08838834764831845f);
        else if (col < C_VB) KB[(size_t)row * DM + col - C_KB] = (bf16)f2bf(v);
        else if (col < C_GA) VBT[(size_t)(col - C_VB) * MTOK + row] = (bf16)f2bf(v);
        else if (col < C_GB) GA[(size_t)row * DM + col - C_GA] = (bf16)f2bf(sigmoidf_(v));
        else GB[(size_t)row * DM + col - C_GB] = (bf16)f2bf(sigmoidf_(v));
    } };
struct GEpiGateA { float* TMP; const bf16* GA; __device__ __forceinline__ void operator()(int row, int col, float v) const { const size_t i = (size_t)row * DM + col; TMP[i] = v * bf2f(GA[i]); } };
struct GEpiGateB { const float* TMP; const bf16* GB; bf16* MIX; __device__ __forceinline__ void operator()(int row, int col, float v) const { const size_t i = (size_t)row * DM + col; MIX[i] = (bf16)f2bf(TMP[i] + v * bf2f(GB[i])); } };
struct GEpiF32 { float* C; int ldc; __device__ __forceinline__ void operator()(int row, int col, float v) const { C[(size_t)row * ldc + col] = v; } };
struct GEpiRelu2 { bf16* O; int ldc; __device__ __forceinline__ void operator()(int row, int col, float v) const { const float t = fmaxf(v, 0.f); O[(size_t)row * ldc + col] = (bf16)f2bf(t * t); } };

__device__ __forceinline__ void p0_mod(Frame& F) {
    LAS float* cact = (LAS float*)F.lds;
    LAS float* red = (LAS float*)(F.lds + 32768);
    for (int i = F.tid; i < NB * DM; i += NTHR) { const float v = F.c[i]; cact[i] = v * sigmoidf_(v); }
    __syncthreads();
    float* MOD = WSP(float, WS_MOD);
    for (int u = F.bx; u < DEPTH * 48; u += F.G) {
        const int l = u / 48, n0 = (u % 48) * 256;
        const float* W = F.w_ada + (size_t)l * DM * (6 * DM) + n0 + 4 * F.lane;
        f32x4 acc[4];
#pragma unroll
        for (int b = 0; b < 4; ++b) acc[b] = (f32x4){0.f, 0.f, 0.f, 0.f};
        const int kb = F.wave * 256;
#pragma unroll 8
        for (int k = 0; k < 256; ++k) {
            const f32x4 wv = *(const f32x4*)(W + (size_t)(kb + k) * (6 * DM));
#pragma unroll
            for (int b = 0; b < 4; ++b) acc[b] += cact[b * DM + kb + k] * wv;
        }
#pragma unroll
        for (int b = 0; b < 4; ++b) *(LAS f32x4*)(red + (F.wave * 4 + b) * 256 + 4 * F.lane) = acc[b];
        __syncthreads();
#pragma unroll
        for (int i = 0; i < 2; ++i) {
            const int o = F.tid * 2 + i, b = o >> 8, col = o & 255; float s = F.b_ada[(size_t)l * 6 * DM + n0 + col];
#pragma unroll
            for (int w = 0; w < 8; ++w) s += red[(w * 4 + b) * 256 + col];
            MOD[(size_t)(l * NB + b) * (6 * DM) + n0 + col] = s;
        }
        __syncthreads();
    }
}

__device__ __forceinline__ int win_src_col(int d) {
    if (d < 1024) return C_QA + d;
    if (d < 3072) return C_RA + d - 1024;
    if (d < 5120) return C_QB + d - 3072;
    if (d < 7168) return C_KB + d - 5120;
    if (d < 9216) return C_GA + d - 7168;
    if (d < 11264) return C_GB + d - 9216;
    if (d < 12288) return C_KA + d - 11264;
    if (d < 14336) return C_VA + d - 12288;
    return C_VB + d - 14336;
}
__device__ __forceinline__ void tr_item(const float* src, int lds_, bf16* dst, int ldd, LAS float* scr, int lane) {
#pragma unroll 8
    for (int i = 0; i < 32; ++i) { const int kk = 2 * i + (lane >> 5); scr[kk * 33 + (lane & 31)] = src[(size_t)kk * lds_ + (lane & 31)]; }
    LDS_WAIT(); asm volatile("" ::: "memory");
    const int c = lane & 7;
#pragma unroll
    for (int j = 0; j < 4; ++j) { const int n = (lane >> 3) + 8 * j; const LAS float* s = scr + (8 * c) * 33 + n;
        v4u o; o.x = pk2(s[0 * 33], s[1 * 33]); o.y = pk2(s[2 * 33], s[3 * 33]); o.z = pk2(s[4 * 33], s[5 * 33]); o.w = pk2(s[6 * 33], s[7 * 33]);
        *(v4u*)(dst + (size_t)n * ldd + 8 * c) = o; }
    LDS_WAIT(); asm volatile("" ::: "memory");
}
__device__ __forceinline__ void p0_transposes(Frame& F) {
    LAS float* scr = (LAS float*)(F.lds + F.wave * 16384);
    const int gw = F.bx * NWAVES + F.wave, ngw = F.G * NWAVES, lane = F.lane;
    constexpr int I_IN = 32 * 512, I_SQ = 32 * 64, I_F1 = 32 * 256, I_F2 = 128 * 64, I_L = I_IN + 3 * I_SQ + I_F1 + I_F2;
    for (int it = gw; it < DEPTH * I_L; it += ngw) {
        const int l = it / I_L; int r = it % I_L; unsigned char* wl = F.ws + WS_W + (size_t)l * WL_STRIDE;
        if (r < I_IN) { const int kb = r / 512, d0 = (r % 512) * 32;
            tr_item(F.w_in + (size_t)l * DM * INCOLS + (size_t)(kb * 64) * INCOLS + win_src_col(d0), INCOLS, (bf16*)(wl + WL_IN) + (size_t)d0 * DM + kb * 64, DM, scr, lane); continue; }
        r -= I_IN;
        if (r < I_SQ) { const int kb = r / 64, n0 = (r % 64) * 32;
            tr_item(F.w_go + (size_t)l * DM * DM + (size_t)(kb * 64) * DM + n0, DM, (bf16*)(wl + WL_GO) + (size_t)n0 * DM + kb * 64, DM, scr, lane); continue; }
        r -= I_SQ;
        if (r < I_SQ) { const int kb = r / 64, n0 = (r % 64) * 32;
            tr_item(F.w_so + (size_t)l * DM * DM + (size_t)(kb * 64) * DM + n0, DM, (bf16*)(wl + WL_SO) + (size_t)n0 * DM + kb * 64, DM, scr, lane); continue; }
        r -= I_SQ;
        if (r < I_SQ) { const int kb = r / 64, n0 = (r % 64) * 32;
            tr_item(F.w_out + (size_t)l * DM * DM + (size_t)(kb * 64) * DM + n0, DM, (bf16*)(wl + WL_OUT) + (size_t)n0 * DM + kb * 64, DM, scr, lane); continue; }
        r -= I_SQ;
        if (r < I_F1) { const int kb = r / 256, n0 = (r % 256) * 32;
            tr_item(F.w_ff1 + (size_t)l * DM * DFF + (size_t)(kb * 64) * DFF + n0, DFF, (bf16*)(wl + WL_FF1) + (size_t)n0 * DM + kb * 64, DM, scr, lane); continue; }
        r -= I_F1;
        { const int kb = r / 64, n0 = (r % 64) * 32;
            tr_item(F.w_ff2 + (size_t)l * DFF * DM + (size_t)(kb * 64) * DM + n0, DM, (bf16*)(wl + WL_FF2) + (size_t)n0 * DFF + kb * 64, DFF, scr, lane); }
    }
}

__device__ __forceinline__ void row_load(const float* p, int lane, f32x4 (&v)[8]) {
#pragma unroll
    for (int j = 0; j < 8; ++j) v[j] = *(const f32x4*)(p + 256 * j + 4 * lane);
}
__device__ __forceinline__ float row_rstd(const f32x4 (&v)[8]) {
    float s = 0.f;
#pragma unroll
    for (int j = 0; j < 8; ++j) s += (v[j].x * v[j].x + v[j].y * v[j].y) + (v[j].z * v[j].z + v[j].w * v[j].w);
    return rsqrtf(wave_sum(s) * (1.f / DM) + EPS);
}
__device__ __forceinline__ void row_emit_h(const f32x4 (&x)[8], const float* ng, const float* sc, const float* sh, bf16* hrow, int lane) {
    const float rs = row_rstd(x);
#pragma unroll
    for (int j = 0; j < 8; ++j) {
        const int o = 256 * j + 4 * lane;
        const f32x4 g = *(const f32x4*)(ng + o), s = *(const f32x4*)(sc + o), t = *(const f32x4*)(sh + o);
        const f32x4 hv = x[j] * rs * g * (1.f + s) + t;
        v2u w; w.x = pk2(hv.x, hv.y); w.y = pk2(hv.z, hv.w);
        *(v2u*)(hrow + o) = w;
    }
}
template <int MODE> __device__ __forceinline__ void row_phase(Frame& F, int l) {
    const int gw = F.bx * NWAVES + F.wave, ngw = F.G * NWAVES, lane = F.lane;
    const float* MOD = WSP(float, WS_MOD); bf16* H = WSP(bf16, WS_H); const float* M2 = WSP(float, WS_M2);
    for (int m = gw; m < MTOK; m += ngw) {
        const int b = m / SEQ; const float* modp = MOD + (size_t)(l * NB + b) * (6 * DM);
        f32x4 x[8];
        if (MODE == 0) {
            row_load(F.x + (size_t)m * DM, lane, x);
            row_emit_h(x, F.ng + (size_t)(l * 4 + 0) * DM, modp + DM, modp, H + (size_t)m * DM, lane);
        } else {
            const float* xs = ((MODE == 1 && l == 0) ? F.x : F.out) + (size_t)m * DM;
            row_load(xs, lane, x);
            f32x4 y[8]; row_load(M2 + (size_t)m * DM, lane, y);
            const float rs = row_rstd(y);
            const float* g = modp + (MODE == 1 ? 2 * DM : 5 * DM); const float* ngy = F.ng + (size_t)(l * 4 + (MODE == 1 ? 1 : 3)) * DM;
#pragma unroll
            for (int j = 0; j < 8; ++j) { const int o = 256 * j + 4 * lane; const f32x4 gv = *(const f32x4*)(g + o), nv = *(const f32x4*)(ngy + o);
                x[j] = x[j] + gv * (y[j] * rs * nv); *(f32x4*)(F.out + (size_t)m * DM + o) = x[j]; }
            if (MODE == 1) row_emit_h(x, F.ng + (size_t)(l * 4 + 2) * DM, modp + 4 * DM, modp + 3 * DM, H + (size_t)m * DM, lane);
            else if (l + 1 < DEPTH) { const float* modn = MOD + (size_t)((l + 1) * NB + b) * (6 * DM);
                row_emit_h(x, F.ng + (size_t)((l + 1) * 4 + 0) * DM, modn + DM, modn, H + (size_t)m * DM, lane); }
        }
    }
}

__device__ __forceinline__ void gcalc(Frame& F, int l) {
    LAS float* al = (LAS float*)F.lds;
    const bf16* H = WSP(bf16, WS_H); bf16* GT = WSP(bf16, WS_GT); float* DEC = WSP(float, WS_DEC);
    for (int u = F.bx; u < 256; u += F.G) {
        const int cc = u >> 1, kd = (u & 1) * 512 + F.tid;
        {
            const int t = F.tid >> 3, r0 = (F.tid & 7) * 2; float a0 = 0.f, a1 = 0.f;
            const bf16* hp = H + (size_t)(cc * 64 + t) * DM; const float* wp = F.w_in + (size_t)l * DM * INCOLS + C_AL + r0;
            for (int k0 = 0; k0 < DM; k0 += 8) {
                const v4u hv = *(const v4u*)(hp + k0);
                const float hh[8] = {bf2f(hv.x & 0xffffu), bf2f(hv.x >> 16), bf2f(hv.y & 0xffffu), bf2f(hv.y >> 16), bf2f(hv.z & 0xffffu), bf2f(hv.z >> 16), bf2f(hv.w & 0xffffu), bf2f(hv.w >> 16)};
#pragma unroll
                for (int i = 0; i < 8; ++i) { const f32x2 w = *(const f32x2*)(wp + (size_t)(k0 + i) * INCOLS); a0 += hh[i] * bf2f(f2bf(w.x)); a1 += hh[i] * bf2f(f2bf(w.y)); }
            }
            al[t * 16 + r0] = a0; al[t * 16 + r0 + 1] = a1;
        }
        __syncthreads();
        float wg[16];
#pragma unroll
        for (int r = 0; r < 16; ++r) wg[r] = F.w_gu[(size_t)(l * RANK + r) * GK + kd];
        const float bg = F.b_gate[(size_t)l * GK + kd];
        float la[64];
#pragma unroll
        for (int t = 0; t < 64; ++t) { float s = bg;
#pragma unroll
            for (int r = 0; r < 16; ++r) s += al[t * 16 + r] * wg[r];
            la[t] = logsig(s) * 0.0625f; }
        float suf = 0.f;
#pragma unroll
        for (int t8 = 7; t8 >= 0; --t8) { float g[8];
#pragma unroll
            for (int i = 7; i >= 0; --i) { g[i] = __expf(suf); suf += la[t8 * 8 + i]; }
            v4u w; w.x = pk2(g[0], g[1]); w.y = pk2(g[2], g[3]); w.z = pk2(g[4], g[5]); w.w = pk2(g[6], g[7]);
            *(v4u*)(GT + (size_t)kd * MTOK + cc * 64 + t8 * 8) = w; }
        DEC[(size_t)cc * GK + kd] = __expf(suf);
        __syncthreads();
    }
}

__device__ __forceinline__ void gla_gold(Frame& F) {
    LAS float* S = (LAS float*)F.lds;
    LAS float* vv = (LAS float*)(F.lds + 33792);
    LAS bf16* kp = (LAS bf16*)(F.lds + 33792 + 8320);
    LAS bf16* qq = (LAS bf16*)(F.lds + 33792 + 8320 + 33792);
    const bf16* KAT = WSP(bf16, WS_KAT); const bf16* GT = WSP(bf16, WS_GT); const bf16* VAT = WSP(bf16, WS_VAT); const bf16* QA = WSP(bf16, WS_QA);
    const float* DEC = WSP(float, WS_DEC); bf16* OG = WSP(bf16, WS_OG);
    for (int u = F.bx; u < 256; u += F.G) {
        const int b = u >> 6, hg = (u >> 4) & 3, vs = u & 15;
        for (int i = F.tid; i < 256 * 33; i += NTHR) S[i] = 0.f;
        __syncthreads();
        for (int c = 0; c < 32; ++c) {
            const int T0 = b * SEQ + c * 64, cc = b * 32 + c;
            { const int k = F.tid >> 1, t0 = (F.tid & 1) * 32; const size_t go = (size_t)(hg * GDK + k) * MTOK + T0 + t0;
#pragma unroll
              for (int i = 0; i < 32; ++i) kp[k * 66 + t0 + i] = (bf16)f2bf(bf2f(KAT[go + i]) * bf2f(GT[go + i])); }
            { const int v = F.tid >> 4, t0 = (F.tid & 15) * 4; const size_t go = (size_t)(hg * GDV + vs * 32 + v) * MTOK + T0 + t0;
#pragma unroll
              for (int i = 0; i < 4; ++i) vv[v * 65 + t0 + i] = bf2f(VAT[go + i]); }
            { const int t = F.tid >> 3, k0 = (F.tid & 7) * 32; const size_t go = (size_t)(T0 + t) * GK + hg * GDK + k0;
#pragma unroll
              for (int i = 0; i < 32; ++i) qq[t * 258 + k0 + i] = QA[go + i]; }
            __syncthreads();
#pragma unroll 1
            for (int i = 0; i < 16; ++i) { const int e = F.tid + 512 * i, k = e >> 5, v = e & 31;
                float acc = S[k * 33 + v] * DEC[(size_t)cc * GK + hg * GDK + k];
                for (int t = 0; t < 64; ++t) acc += bf2f(kp[k * 66 + t]) * vv[v * 65 + t];
                S[k * 33 + v] = acc; }
            __syncthreads();
#pragma unroll 1
            for (int i = 0; i < 4; ++i) { const int e = F.tid + 512 * i, t = e >> 5, v = e & 31; float acc = 0.f;
                for (int k = 0; k < 256; ++k) acc += bf2f(qq[t * 258 + k]) * S[k * 33 + v];
                OG[(size_t)(T0 + t) * GV + hg * GDV + vs * 32 + v] = (bf16)f2bf(acc); }
            __syncthreads();
        }
    }
}

__device__ __forceinline__ void sb_gold(Frame& F) {
    const int gw = F.bx * NWAVES + F.wave, ngw = F.G * NWAVES, lane = F.lane;
    const bf16* QB = WSP(bf16, WS_QB); const bf16* KB = WSP(bf16, WS_KB); const bf16* VBT = WSP(bf16, WS_VBT); bf16* SBO = WSP(bf16, WS_SBO);
    for (int rid = gw; rid < NB * SH * SEQ; rid += ngw) {
        const int t = rid % SEQ, bh = rid / SEQ, b = bh / SH, h = bh % SH;
        const unsigned qw = *(const unsigned*)(QB + (size_t)(b * SEQ + t) * DM + h * SDH + 2 * lane);
        const float q0 = bf2f(qw & 0xffffu), q1 = bf2f(qw >> 16);
        float o0 = 0.f, o1 = 0.f, P = 1.f;
        const bf16* v0p = VBT + (size_t)(h * SDH + 2 * lane) * MTOK + b * SEQ; const bf16* v1p = v0p + MTOK;
        for (int s = t - 1; s >= 0; --s) {
            if (P == 0.f) break;
            const unsigned kw = *(const unsigned*)(KB + (size_t)(b * SEQ + s) * DM + h * SDH + 2 * lane);
            float z = wave_sum(q0 * bf2f(kw & 0xffffu) + q1 * bf2f(kw >> 16));
            z = fminf(fmaxf(z, -80.f), 80.f);
            const float e = __expf(-z), beta = __builtin_amdgcn_rcpf(1.f + e), w = beta * P;
            P *= e * beta;
            o0 += w * bf2f(v0p[s]); o1 += w * bf2f(v1p[s]);
        }
        *(unsigned*)(SBO + (size_t)(b * SEQ + t) * DM + h * SDH + 2 * lane) = pk2(o0, o1);
    }
}

typedef __bf16 bf16x2v __attribute__((ext_vector_type(2)));
__device__ __forceinline__ unsigned cvtpk(float lo, float hi) { f32x2 v = {lo, hi}; bf16x2v b = __builtin_convertvector(v, bf16x2v); return __builtin_bit_cast(unsigned, b); }
__device__ __forceinline__ float blo(unsigned w) { return __uint_as_float(w << 16); }
__device__ __forceinline__ float bhi(unsigned w) { return __uint_as_float(w & 0xffff0000u); }
__device__ __forceinline__ void gla_fast(Frame& F) {
    LAS float* Pl = (LAS float*)F.lds;
    const bf16* KAT = WSP(bf16, WS_KAT); const bf16* GT = WSP(bf16, WS_GT); const bf16* VAT = WSP(bf16, WS_VAT); const bf16* QA = WSP(bf16, WS_QA);
    const float* DEC = WSP(float, WS_DEC); bf16* OG = WSP(bf16, WS_OG);
    const int lane = F.lane, w = F.wave, r31 = lane & 31, hh = lane >> 5, tid = F.tid;
    for (int u = F.bx; u < 256; u += F.G) {
        const int b = u >> 6, hg = (u >> 4) & 3, vs = u & 15;
        f32x16 S;
#pragma unroll
        for (int e = 0; e < 16; ++e) S[e] = 0.f;
        const bf16* kp_ = KAT + (size_t)(hg * GDK + 32 * w + r31) * MTOK + b * SEQ + 8 * hh;
        const bf16* gp_ = GT + (size_t)(hg * GDK + 32 * w + r31) * MTOK + b * SEQ + 8 * hh;
        const bf16* vp_ = VAT + (size_t)(hg * GDV + vs * 32 + r31) * MTOK + b * SEQ + 8 * hh;
        const float* dp_ = DEC + (size_t)(b * 32) * GK + hg * GDK + 32 * w + 4 * hh;
        const bf16* qp_ = QA + (size_t)(b * SEQ + r31) * GK + hg * GDK + 32 * w + 4 * hh;
        for (int c = 0; c < 32; ++c) {
            const int T0 = c * 64;
            v4u kA[4], gA[4], vB[4]; f32x4 dc[4]; v2u qA[2][2][2];
#pragma unroll
            for (int s_ = 0; s_ < 4; ++s_) { kA[s_] = *(const v4u*)(kp_ + T0 + 16 * s_); gA[s_] = *(const v4u*)(gp_ + T0 + 16 * s_); vB[s_] = *(const v4u*)(vp_ + T0 + 16 * s_); dc[s_] = *(const f32x4*)(dp_ + (size_t)c * GK + 8 * s_); }
#pragma unroll
            for (int tb = 0; tb < 2; ++tb)
#pragma unroll
                for (int s2 = 0; s2 < 2; ++s2) { const bf16* q = qp_ + (size_t)(T0 + tb * 32) * GK + 16 * s2; qA[tb][s2][0] = *(const v2u*)q; qA[tb][s2][1] = *(const v2u*)(q + 8); }
#pragma unroll
            for (int e = 0; e < 16; ++e) S[e] *= dc[e >> 2][e & 3];
#pragma unroll
            for (int s_ = 0; s_ < 4; ++s_) {
                v4u kpk;
                kpk.x = cvtpk(blo(kA[s_].x) * blo(gA[s_].x), bhi(kA[s_].x) * bhi(gA[s_].x)); kpk.y = cvtpk(blo(kA[s_].y) * blo(gA[s_].y), bhi(kA[s_].y) * bhi(gA[s_].y));
                kpk.z = cvtpk(blo(kA[s_].z) * blo(gA[s_].z), bhi(kA[s_].z) * bhi(gA[s_].z)); kpk.w = cvtpk(blo(kA[s_].w) * blo(gA[s_].w), bhi(kA[s_].w) * bhi(gA[s_].w));
                S = __builtin_amdgcn_mfma_f32_32x32x16_bf16(__builtin_bit_cast(bf16x8, kpk), __builtin_bit_cast(bf16x8, vB[s_]), S, 0, 0, 0);
            }
            v4u sf[2];
#pragma unroll
            for (int s2 = 0; s2 < 2; ++s2) { sf[s2].x = cvtpk(S[8 * s2 + 0], S[8 * s2 + 1]); sf[s2].y = cvtpk(S[8 * s2 + 2], S[8 * s2 + 3]); sf[s2].z = cvtpk(S[8 * s2 + 4], S[8 * s2 + 5]); sf[s2].w = cvtpk(S[8 * s2 + 6], S[8 * s2 + 7]); }
            LAS float* pl = Pl + (size_t)(c & 1) * 16384 + w * 2048;
#pragma unroll
            for (int tb = 0; tb < 2; ++tb) {
                f32x16 po;
#pragma unroll
                for (int e = 0; e < 16; ++e) po[e] = 0.f;
#pragma unroll
                for (int s2 = 0; s2 < 2; ++s2) { v4u a; a.x = qA[tb][s2][0].x; a.y = qA[tb][s2][0].y; a.z = qA[tb][s2][1].x; a.w = qA[tb][s2][1].y;
                    po = __builtin_amdgcn_mfma_f32_32x32x16_bf16(__builtin_bit_cast(bf16x8, a), __builtin_bit_cast(bf16x8, sf[s2]), po, 0, 0, 0); }
#pragma unroll
                for (int e = 0; e < 16; ++e) pl[(tb * 32 + (e & 3) + 8 * (e >> 2) + 4 * hh) * 32 + r31] = po[e];
            }
            __syncthreads();
            {   const int tok = tid >> 3, v4 = (tid & 7) * 4; const LAS float* rp = Pl + (size_t)(c & 1) * 16384 + tok * 32 + v4;
                f32x4 acc = *(const LAS f32x4*)rp;
#pragma unroll
                for (int ww = 1; ww < 8; ++ww) acc += *(const LAS f32x4*)(rp + ww * 2048);
                v2u o2; o2.x = cvtpk(acc.x, acc.y); o2.y = cvtpk(acc.z, acc.w);
                *(v2u*)(OG + (size_t)(b * SEQ + T0 + tok) * GV + hg * GDV + vs * 32 + v4) = o2; }
        }
        __syncthreads();
    }
}

__device__ __forceinline__ void sb_fast(Frame& F) {
    LAS unsigned char* Kt = F.lds;
    LAS unsigned char* Vt = F.lds + 2 * 17408;
    volatile LAS unsigned* flg = (volatile LAS unsigned*)(F.lds + 4 * 17408);
    const bf16* QB = WSP(bf16, WS_QB); const bf16* KB = WSP(bf16, WS_KB); const bf16* VBT = WSP(bf16, WS_VBT); bf16* SBO = WSP(bf16, WS_SBO);
    const int lane = F.lane, wave = F.wave, r31 = lane & 31, hh = lane >> 5, tid = F.tid;
    for (int u = F.bx; u < 512; u += F.G) {
        const int bh = u >> 3, qb = u & 7, b = bh >> 4, h = bh & 15;
        const int t = qb * 256 + 32 * wave + r31, twmax = qb * 256 + 32 * wave + 31;
        v4u qf[8];
        { const bf16* qp = QB + (size_t)(b * SEQ + t) * DM + h * SDH + 8 * hh;
#pragma unroll
          for (int s_ = 0; s_ < 8; ++s_) qf[s_] = *(const v4u*)(qp + 16 * s_); }
        f32x16 o[4];
#pragma unroll
        for (int d = 0; d < 4; ++d)
#pragma unroll
            for (int e = 0; e < 16; ++e) o[d][e] = 0.f;
        float P = 1.f;
        const int kt_hi = qb * 4 + 3;
        const int c0 = tid, c1 = tid + 512;
        const bf16* kg0 = KB + (size_t)(b * SEQ + (c0 >> 4)) * DM + h * SDH + (c0 & 15) * 8; const bf16* kg1 = KB + (size_t)(b * SEQ + (c1 >> 4)) * DM + h * SDH + (c1 & 15) * 8;
        const bf16* vg0 = VBT + (size_t)(h * SDH + (c0 >> 3)) * MTOK + b * SEQ + (c0 & 7) * 8; const bf16* vg1 = VBT + (size_t)(h * SDH + (c1 >> 3)) * MTOK + b * SEQ + (c1 & 7) * 8;
        const int kl0 = (c0 >> 4) * 272 + (c0 & 15) * 16, kl1 = (c1 >> 4) * 272 + (c1 & 15) * 16, vl0 = (c0 >> 3) * 136 + (c0 & 7) * 16, vl1 = (c1 >> 3) * 136 + (c1 & 7) * 16;
        v4u rk0, rk1, rv0, rv1;
        rk0 = *(const v4u*)(kg0 + (size_t)kt_hi * 64 * DM); rk1 = *(const v4u*)(kg1 + (size_t)kt_hi * 64 * DM); rv0 = *(const v4u*)(vg0 + kt_hi * 64); rv1 = *(const v4u*)(vg1 + kt_hi * 64);
        *(LAS v4u*)(Kt + kl0) = rk0; *(LAS v4u*)(Kt + kl1) = rk1;
        *(LAS v2u*)(Vt + vl0) = (v2u){rv0.x, rv0.y}; *(LAS v2u*)(Vt + vl0 + 8) = (v2u){rv0.z, rv0.w}; *(LAS v2u*)(Vt + vl1) = (v2u){rv1.x, rv1.y}; *(LAS v2u*)(Vt + vl1 + 8) = (v2u){rv1.z, rv1.w};
        __syncthreads();
        int it = 0;
        for (int kt = kt_hi; kt >= 0; --kt, ++it) {
            const int buf = it & 1;
            if (kt > 0) { rk0 = *(const v4u*)(kg0 + (size_t)(kt - 1) * 64 * DM); rk1 = *(const v4u*)(kg1 + (size_t)(kt - 1) * 64 * DM); rv0 = *(const v4u*)(vg0 + (kt - 1) * 64); rv1 = *(const v4u*)(vg1 + (kt - 1) * 64); }
            const bool alive = __builtin_amdgcn_ballot_w64(P != 0.f) != 0ull;
            if (alive && kt * 64 < twmax) {
                const LAS unsigned char* kb_ = Kt + buf * 17408 + r31 * 272 + 16 * hh;
                f32x16 sa[2];
#pragma unroll
                for (int kb = 0; kb < 2; ++kb) {
#pragma unroll
                    for (int e = 0; e < 16; ++e) sa[kb][e] = 0.f;
#pragma unroll
                    for (int s_ = 0; s_ < 8; ++s_) { const v4u a = *(const LAS v4u*)(kb_ + kb * 32 * 272 + 32 * s_);
                        sa[kb] = __builtin_amdgcn_mfma_f32_32x32x16_bf16(__builtin_bit_cast(bf16x8, a), __builtin_bit_cast(bf16x8, qf[s_]), sa[kb], 0, 0, 0); }
                }
                float run = P; v4u pf[2][2];
#pragma unroll
                for (int kb = 1; kb >= 0; --kb) {
                    float be[16], om[16];
#pragma unroll
                    for (int e = 0; e < 16; ++e) { const int key = kt * 64 + kb * 32 + (e & 3) + 8 * (e >> 2) + 4 * hh;
                        const float z = fminf(fmaxf(sa[kb][e], -80.f), 80.f), ex = __expf(-z), bt = __builtin_amdgcn_rcpf(1.f + ex); const bool msk = key >= t;
                        be[e] = msk ? 0.f : bt; om[e] = msk ? 1.f : ex * bt; }
                    float wv[16];
#pragma unroll
                    for (int g = 3; g >= 0; --g) {
                        const float x2 = om[4 * g + 3], x1 = x2 * om[4 * g + 2], x0 = x1 * om[4 * g + 1], Gp = x0 * om[4 * g], Pp = __shfl_xor(Gp, 32);
                        const float ag = hh == 0 ? run * Pp : run;
                        wv[4 * g + 3] = be[4 * g + 3] * ag; wv[4 * g + 2] = be[4 * g + 2] * (x2 * ag); wv[4 * g + 1] = be[4 * g + 1] * (x1 * ag); wv[4 * g] = be[4 * g] * (x0 * ag);
                        run *= Gp * Pp; }
#pragma unroll
                    for (int s2 = 0; s2 < 2; ++s2) { pf[kb][s2].x = cvtpk(wv[8 * s2], wv[8 * s2 + 1]); pf[kb][s2].y = cvtpk(wv[8 * s2 + 2], wv[8 * s2 + 3]); pf[kb][s2].z = cvtpk(wv[8 * s2 + 4], wv[8 * s2 + 5]); pf[kb][s2].w = cvtpk(wv[8 * s2 + 6], wv[8 * s2 + 7]); }
                }
                P = run;
                const LAS unsigned char* vb_ = Vt + buf * 17408 + r31 * 136 + 8 * hh;
#pragma unroll
                for (int d = 0; d < 4; ++d)
#pragma unroll
                    for (int kb = 0; kb < 2; ++kb)
#pragma unroll
                        for (int s2 = 0; s2 < 2; ++s2) { const LAS unsigned char* p = vb_ + d * 32 * 136 + (kb * 32 + 16 * s2) * 2; const v2u lo = *(const LAS v2u*)p, hi = *(const LAS v2u*)(p + 16);
                            const v4u a = {lo.x, lo.y, hi.x, hi.y};
                            o[d] = __builtin_amdgcn_mfma_f32_32x32x16_bf16(__builtin_bit_cast(bf16x8, a), __builtin_bit_cast(bf16x8, pf[kb][s2]), o[d], 0, 0, 0); }
            }
            if (lane == 0) flg[buf * 8 + wave] = (__builtin_amdgcn_ballot_w64(P != 0.f) == 0ull) ? 1u : 0u;
            if (kt > 0) { const int nb = (buf ^ 1) * 17408;
                *(LAS v4u*)(Kt + nb + kl0) = rk0; *(LAS v4u*)(Kt + nb + kl1) = rk1;
                *(LAS v2u*)(Vt + nb + vl0) = (v2u){rv0.x, rv0.y}; *(LAS v2u*)(Vt + nb + vl0 + 8) = (v2u){rv0.z, rv0.w}; *(LAS v2u*)(Vt + nb + vl1) = (v2u){rv1.x, rv1.y}; *(LAS v2u*)(Vt + nb + vl1 + 8) = (v2u){rv1.z, rv1.w}; }
            __syncthreads();
            unsigned nd = 0;
#pragma unroll
            for (int i = 0; i < 8; ++i) nd += flg[buf * 8 + i];
            if (nd == 8u) break;
        }
        { bf16* op = SBO + (size_t)(b * SEQ + t) * DM + h * SDH + 4 * hh;
#pragma unroll
          for (int d = 0; d < 4; ++d)
#pragma unroll
              for (int g = 0; g < 4; ++g) { v2u w2; w2.x = cvtpk(o[d][4 * g], o[d][4 * g + 1]); w2.y = cvtpk(o[d][4 * g + 2], o[d][4 * g + 3]); *(v2u*)(op + d * 32 + 8 * g) = w2; } }
        __syncthreads();
    }
}

__device__ __forceinline__ void gla_gate(Frame& F, int l) {
    const int gw = F.bx * NWAVES + F.wave, ngw = F.G * NWAVES, lane = F.lane;
    const bf16* OG = WSP(bf16, WS_OG); const bf16* RA = WSP(bf16, WS_RA); bf16* GIN = WSP(bf16, WS_GIN);
    for (int m = gw; m < MTOK; m += ngw) {
#pragma unroll
        for (int hg = 0; hg < 4; ++hg) {
            const size_t o = (size_t)m * GV + hg * GDV + 8 * lane;
            const v4u ov = *(const v4u*)(OG + o), rv = *(const v4u*)(RA + o);
            float x[8]; x[0] = bf2f(ov.x & 0xffffu); x[1] = bf2f(ov.x >> 16); x[2] = bf2f(ov.y & 0xffffu); x[3] = bf2f(ov.y >> 16);
            x[4] = bf2f(ov.z & 0xffffu); x[5] = bf2f(ov.z >> 16); x[6] = bf2f(ov.w & 0xffffu); x[7] = bf2f(ov.w >> 16);
            float r[8]; r[0] = bf2f(rv.x & 0xffffu); r[1] = bf2f(rv.x >> 16); r[2] = bf2f(rv.y & 0xffffu); r[3] = bf2f(rv.y >> 16);
            r[4] = bf2f(rv.z & 0xffffu); r[5] = bf2f(rv.z >> 16); r[6] = bf2f(rv.w & 0xffffu); r[7] = bf2f(rv.w >> 16);
            float s = 0.f;
#pragma unroll
            for (int i = 0; i < 8; ++i) s += x[i] * x[i];
            const float rs = rsqrtf(wave_sum(s) * (1.f / GDV) + EPS);
            const float* gp = F.gn + (size_t)(l * GH + hg) * GDV + 8 * lane;
            const f32x4 g0 = *(const f32x4*)gp, g1 = *(const f32x4*)(gp + 4);
            const float gg[8] = {g0.x, g0.y, g0.z, g0.w, g1.x, g1.y, g1.z, g1.w};
            float y[8];
#pragma unroll
            for (int i = 0; i < 8; ++i) y[i] = x[i] * rs * gg[i] * r[i];
            v4u w; w.x = pk2(y[0], y[1]); w.y = pk2(y[2], y[3]); w.z = pk2(y[4], y[5]); w.w = pk2(y[6], y[7]);
            *(v4u*)(GIN + o) = w;
        }
    }
}

constexpr int NPHASE = 2 + 9 * DEPTH;
struct Args { const float* in[14]; float* out; unsigned char* ws; int ph_lo, ph_hi, use_bar, pad; };
__global__ void __launch_bounds__(NTHR, 2) fwd(Args args) {
    extern __shared__ __attribute__((aligned(16))) unsigned char lds[];
    Frame F;
    F.lds = (LAS unsigned char*)lds; F.tid = threadIdx.x; F.lane = F.tid & 63; F.wave = __builtin_amdgcn_readfirstlane(F.tid >> 6); F.G = gridDim.x; F.bx = blockIdx.x;
    F.x = args.in[0]; F.c = args.in[1]; F.w_ada = args.in[2]; F.b_ada = args.in[3]; F.ng = args.in[4]; F.w_in = args.in[5]; F.w_gu = args.in[6]; F.b_gate = args.in[7];
    F.gn = args.in[8]; F.w_go = args.in[9]; F.w_so = args.in[10]; F.w_out = args.in[11]; F.w_ff1 = args.in[12]; F.w_ff2 = args.in[13]; F.out = args.out; F.ws = args.ws;
    volatile LAS unsigned* MISC = (volatile LAS unsigned*)(F.lds + MISC_OFF);
    for (int u = F.tid; u < (LDS_BYTES - LDSCTL_OFF) / 4; u += NTHR) ((LAS unsigned*)(F.lds + LDSCTL_OFF))[u] = 0u;
    __syncthreads();
    XcdBarrier bar; bar.bar = (unsigned*)(F.ws + WS_CTL) + CW_BAR; bar.x = 0; bar.st = nullptr;
    if (args.use_bar) bar = xcd_barrier_post((unsigned*)(F.ws + WS_CTL) + CW_BAR, MISC + 8);
    const int lo = args.ph_lo, hi = args.ph_hi;
#define IN(k) (lo <= (k) && (k) < hi)
#define SEAM(k) do { if (IN(k) && IN((k) + 1)) xcd_barrier(bar); } while (0)

    if (IN(0)) { p0_mod(F); if (FAST_GEMM) p0_transposes(F); } SEAM(0);
    if (IN(1)) { row_phase<0>(F, 0); } SEAM(1);
    for (int l = 0; l < DEPTH; ++l) {
        const int pb = 2 + 9 * l;
        { int t_ = threadIdx.x; asm volatile("" : "+v"(t_)); F.tid = t_; F.lane = t_ & 63; }
        if (IN(pb + 0)) {
            gcalc(F, l);
            if (FAST_GEMM & 1) {
                __syncthreads();
                pg8::Gemm g{WSP(bf16, WS_H), (const bf16*)(F.ws + WS_W + (size_t)l * WL_STRIDE + WL_IN), MTOK, 16384, DM}; pg8::ProjOrder S; S.init(MTOK, 16384, F.G, F.bx);
                pg8::EpiProj E{WSP(bf16, WS_QA), WSP(bf16, WS_RA), WSP(bf16, WS_QB), WSP(bf16, WS_KB), WSP(bf16, WS_GA), WSP(bf16, WS_GB), WSP(bf16, WS_KAT), WSP(bf16, WS_VAT), WSP(bf16, WS_VBT)};
                pg8::gemm_phase<pg8::EpiProj, pg8::ProjOrder, true, true>(F.lds, g, S, E);
            } else {
            GEpiProj E{WSP(bf16, WS_QA), WSP(bf16, WS_RA), WSP(bf16, WS_QB), WSP(bf16, WS_KB), WSP(bf16, WS_GA), WSP(bf16, WS_GB), WSP(bf16, WS_KAT), WSP(bf16, WS_VAT), WSP(bf16, WS_VBT)};
            gold_gemm(F, WSP(bf16, WS_H), DM, F.w_in + (size_t)l * DM * INCOLS, INCOLS, MTOK, INCOLS, DM, E);
            }
        } SEAM(pb + 0);
        if (IN(pb + 1)) {
            if (FAST_GLA) gla_fast(F); else gla_gold(F);
            __syncthreads();
            if (FAST_SB) sb_fast(F); else sb_gold(F);
        } SEAM(pb + 1);
        if (IN(pb + 2)) { gla_gate(F, l); } SEAM(pb + 2);
        if (IN(pb + 3)) {
            if (FAST_GEMM & 2) {
                const unsigned char* wl = F.ws + WS_W + (size_t)l * WL_STRIDE;
                { pg8::Gemm g{WSP(bf16, WS_GIN), (const bf16*)(wl + WL_GO), MTOK, DM, GV}; pg8::StaticOrder S; S.init(MTOK, DM, F.G, F.bx);
                  pg8::EpiGateA E{WSP(float, WS_TMP), WSP(bf16, WS_GA), DM}; pg8::gemm_phase<pg8::EpiGateA, pg8::StaticOrder, false, true>(F.lds, g, S, E); }
                { pg8::Gemm g{WSP(bf16, WS_SBO), (const bf16*)(wl + WL_SO), MTOK, DM, DM}; pg8::StaticOrder S; S.init(MTOK, DM, F.G, F.bx);
                  pg8::EpiGateB E{WSP(float, WS_TMP), WSP(bf16, WS_GB), WSP(bf16, WS_MIX), DM}; pg8::gemm_phase<pg8::EpiGateB, pg8::StaticOrder, false, true>(F.lds, g, S, E); }
            } else {
            GEpiGateA EA{WSP(float, WS_TMP), WSP(bf16, WS_GA)};
            gold_gemm(F, WSP(bf16, WS_GIN), GV, F.w_go + (size_t)l * GV * DM, DM, MTOK, DM, GV, EA);
            GEpiGateB EB{WSP(float, WS_TMP), WSP(bf16, WS_GB), WSP(bf16, WS_MIX)};
            gold_gemm(F, WSP(bf16, WS_SBO), DM, F.w_so + (size_t)l * DM * DM, DM, MTOK, DM, DM, EB);
            }
        } SEAM(pb + 3);
        if (IN(pb + 4)) {
            if (FAST_GEMM & 4) {
                pg8::Gemm g{WSP(bf16, WS_MIX), (const bf16*)(F.ws + WS_W + (size_t)l * WL_STRIDE + WL_OUT), MTOK, DM, DM}; pg8::StaticOrder S; S.init(MTOK, DM, F.G, F.bx);
                pg8::EpiF32 E{WSP(float, WS_M2), DM}; pg8::gemm_phase<pg8::EpiF32, pg8::StaticOrder, false, true>(F.lds, g, S, E);
            } else {
            GEpiF32 E{WSP(float, WS_M2), DM};
            gold_gemm(F, WSP(bf16, WS_MIX), DM, F.w_out + (size_t)l * DM * DM, DM, MTOK, DM, DM, E);
            }
        } SEAM(pb + 4);
        if (IN(pb + 5)) { row_phase<1>(F, l); } SEAM(pb + 5);
        if (IN(pb + 6)) {
            if (FAST_GEMM & 8) {
                pg8::Gemm g{WSP(bf16, WS_H), (const bf16*)(F.ws + WS_W + (size_t)l * WL_STRIDE + WL_FF1), MTOK, DFF, DM}; pg8::StaticOrder S; S.init(MTOK, DFF, F.G, F.bx);
                pg8::EpiRelu2 E{WSP(bf16, WS_F1), DFF}; pg8::gemm_phase<pg8::EpiRelu2, pg8::StaticOrder, true, true>(F.lds, g, S, E);
            } else {
            GEpiRelu2 E{WSP(bf16, WS_F1), DFF};
            gold_gemm(F, WSP(bf16, WS_H), DM, F.w_ff1 + (size_t)l * DM * DFF, DFF, MTOK, DFF, DM, E);
            }
        } SEAM(pb + 6);
        if (IN(pb + 7)) {
            if (FAST_GEMM & 16) {
                pg8::Gemm g{WSP(bf16, WS_F1), (const bf16*)(F.ws + WS_W + (size_t)l * WL_STRIDE + WL_FF2), MTOK, DM, DFF}; pg8::StaticOrder S; S.init(MTOK, DM, F.G, F.bx);
                pg8::EpiF32 E{WSP(float, WS_M2), DM}; pg8::gemm_phase<pg8::EpiF32, pg8::StaticOrder, false, true>(F.lds, g, S, E);
            } else {
            GEpiF32 E{WSP(float, WS_M2), DM};
            gold_gemm(F, WSP(bf16, WS_F1), DFF, F.w_ff2 + (size_t)l * DFF * DM, DM, MTOK, DM, DFF, E);
            }
        } SEAM(pb + 7);
        if (IN(pb + 8)) { row_phase<2>(F, l); } SEAM(pb + 8);
    }
#undef IN
#undef SEAM
}

extern "C" void kernel_launch(void* const* d_in, const int* in_sizes, int n_in, void* d_out, int out_size, void* d_ws, size_t ws_size, hipStream_t stream) {
    static int grid = 0;
    if (grid == 0) {
        if (n_in != 14 || out_size != MTOK * DM || ws_size < WS_END) { fprintf(stderr, "kernel_launch: unexpected shapes (n_in %d out %d ws %zu)\n", n_in, out_size, ws_size); grid = -1; return; }
        int dev = 0, cus = 0, per_cu = 0;
        if (hipGetDevice(&dev) != hipSuccess || hipDeviceGetAttribute(&cus, hipDeviceAttributeMultiprocessorCount, dev) != hipSuccess) { grid = -1; return; }
        if (hipFuncSetAttribute((const void*)fwd, hipFuncAttributeMaxDynamicSharedMemorySize, LDS_BYTES) != hipSuccess) { fprintf(stderr, "kernel_launch: hipFuncSetAttribute failed\n"); grid = -1; return; }
        if (hipOccupancyMaxActiveBlocksPerMultiprocessor(&per_cu, (const void*)fwd, NTHR, LDS_BYTES) != hipSuccess || per_cu < 1) fprintf(stderr, "kernel_launch: occupancy query says %d\n", per_cu);
        (void)hipGetLastError();
        grid = cus;
    }
    if (grid < 0) return;
    (void)hipMemsetAsync((char*)d_ws + WS_CTL, 0, CTL_ZERO_BYTES, stream);
    Args a{};
    for (int i = 0; i < 14; ++i) a.in[i] = (const float*)d_in[i];
    a.out = (float*)d_out; a.ws = (unsigned char*)d_ws;
#if N_LAUNCHES == 1
    a.ph_lo = 0; a.ph_hi = NPHASE; a.use_bar = 1;
    hipLaunchKernelGGL(fwd, dim3(grid), dim3(NTHR), LDS_BYTES, stream, a);
#else
    for (int p = 0; p < NPHASE; ++p) { a.ph_lo = p; a.ph_hi = p + 1; a.use_bar = 0; hipLaunchKernelGGL(fwd, dim3(grid), dim3(NTHR), LDS_BYTES, stream, a); }
#endif
}
```

```cpp
#include <hip/hip_runtime.h>
#include <cstdio>
#include <cstdint>

#ifndef N_LAUNCHES
#define N_LAUNCHES 1
#endif
#ifndef DUP
#define DUP 0
#endif
#ifndef FAST_GEMM
#define FAST_GEMM 31
#endif
#ifndef FAST_GCALC
#define FAST_GCALC 1
#endif
#ifndef FAST_GLA
#define FAST_GLA 1
#endif
#ifndef FAST_SB
#define FAST_SB 1
#endif

#define GAS __attribute__((address_space(1)))
#define LAS __attribute__((address_space(3)))
typedef unsigned short bf16;
typedef float f32x4 __attribute__((ext_vector_type(4)));
typedef float f32x2 __attribute__((ext_vector_type(2)));
typedef float f32x16 __attribute__((ext_vector_type(16)));
typedef short bf16x8 __attribute__((ext_vector_type(8)));
typedef unsigned v4u __attribute__((ext_vector_type(4)));
typedef unsigned v2u __attribute__((ext_vector_type(2)));
typedef GAS unsigned gu32;
#define RLX_AGENT __ATOMIC_RELAXED, __HIP_MEMORY_SCOPE_AGENT
#define LDS_WAIT() asm volatile("s_waitcnt lgkmcnt(0)" ::: "memory")
#define VM_WAIT() asm volatile("s_waitcnt vmcnt(0)" ::: "memory")

constexpr int DM = 2048, NB = 4, SEQ = 2048, DEPTH = 4, MTOK = NB * SEQ;
constexpr int GH = 4, GDK = 256, GDV = 512, GK = 1024, GV = 2048, RANK = 16, SH = 16, SDH = 128, DFF = 8192, INCOLS = 16400;
constexpr int C_QA = 0, C_KA = 1024, C_VA = 2048, C_RA = 4096, C_AL = 6144, C_QB = 6160, C_KB = 8208, C_VB = 10256, C_GA = 12304, C_GB = 14352;
constexpr float EPS = 1e-6f;
constexpr int NWAVES = 8, NTHR = 512;

constexpr size_t MiB = 1u << 20;
constexpr size_t WS_CTL = 0, CTL_ZERO_BYTES = 1 * MiB;
constexpr size_t WS_MOD = 1 * MiB;
constexpr size_t WS_WA = 2 * MiB;
constexpr size_t WS_DEC = 3 * MiB;
constexpr size_t WS_W = 4 * MiB;
constexpr size_t WL_IN = 0, WL_GO = 64 * MiB, WL_SO = 72 * MiB, WL_OUT = 80 * MiB, WL_FF1 = 88 * MiB, WL_FF2 = 120 * MiB, WL_STRIDE = 152 * MiB;
constexpr size_t WS_H = 612 * MiB;
constexpr size_t WS_PROJ = 644 * MiB;
constexpr size_t WS_QA = WS_PROJ, WS_RA = WS_QA + 16 * MiB, WS_QB = WS_RA + 32 * MiB, WS_KB = WS_QB + 32 * MiB, WS_GA = WS_KB + 32 * MiB, WS_GB = WS_GA + 32 * MiB,
                 WS_KAT = WS_GB + 32 * MiB, WS_VAT = WS_KAT + 16 * MiB, WS_VBT = WS_VAT + 32 * MiB;
constexpr size_t WS_F1 = WS_PROJ;
constexpr size_t WS_GT = 900 * MiB;
constexpr size_t WS_OG = 916 * MiB, WS_GIN = 948 * MiB, WS_SBO = 980 * MiB;
constexpr size_t WS_TMP = 1012 * MiB;
constexpr size_t WS_MIX = 1076 * MiB;
constexpr size_t WS_M2 = 1108 * MiB;
constexpr size_t WS_END = 1172 * MiB;
static_assert(WS_VBT + 32 * MiB == 900 * MiB, "proj map");

constexpr int CW_TMO = 0, CW_CODE = 1, CW_BAR = 4096;
constexpr int RING_BYTES = 131072, LDSCTL_OFF = RING_BYTES, MISC_OFF = LDSCTL_OFF + 320, LDS_BYTES = 147456;

__device__ __forceinline__ float bf2f(unsigned b) { return __uint_as_float(b << 16); }
__device__ __forceinline__ unsigned f2bf(float f) { unsigned u = __float_as_uint(f); return (u + 0x7fffu + ((u >> 16) & 1u)) >> 16; }
__device__ __forceinline__ unsigned pk2(float lo, float hi) { return f2bf(lo) | (f2bf(hi) << 16); }
__device__ __forceinline__ float wave_sum(float v) {
#pragma unroll
    for (int o = 1; o < 64; o <<= 1) v += __shfl_xor(v, o);
    return v;
}
__device__ __forceinline__ float sigmoidf_(float v) { return __builtin_amdgcn_rcpf(1.f + __expf(-v)); }
__device__ __forceinline__ float logsig(float x) { return fminf(x, 0.f) - __logf(1.f + __expf(-fabsf(x))); }

#define XB_TMO      128
#define XB_XCNT(j)  (256  + 64 * (j))
#define XB_XSUB(j)  (1280 + 64 * (j))
#define XB_XGEN(j)  (2304 + 64 * (j))
#define XB_TOP      3328
#define XB_TOPGEN   3392
#define XCD_BAR_WORDS 3456
#define XB_SPIN_CAP (1u << 22)
__device__ __forceinline__ unsigned xb_ld(unsigned* p)              { return __hip_atomic_load(p, __ATOMIC_RELAXED, __HIP_MEMORY_SCOPE_AGENT); }
__device__ __forceinline__ unsigned xb_add(unsigned* p, unsigned v) { return __hip_atomic_fetch_add(p, v, __ATOMIC_RELAXED, __HIP_MEMORY_SCOPE_AGENT); }
__device__ __forceinline__ unsigned xb_xcc_id() { return (unsigned)__builtin_amdgcn_s_getreg((3 << 11) | 20) & 0xFu; }
#define XB_SPIN(cond, bar) do { unsigned _sp = 0; while (cond) { __builtin_amdgcn_s_sleep(1); \
    if ((++_sp & 255u) == 0u) { if (xb_ld(&(bar)[XB_TMO])) break; if (_sp > XB_SPIN_CAP) { atomicAdd(&(bar)[XB_TMO], 1u); break; } } } } while (0)
struct XcdBarrier { unsigned* bar; unsigned x; volatile LAS unsigned* st; };
__device__ __forceinline__ XcdBarrier xcd_barrier_post(unsigned* bar, volatile LAS unsigned* st) {
    XcdBarrier b; b.bar = bar; b.x = xb_xcc_id(); b.st = st;
    if (threadIdx.x == 0) (void)xb_add(&bar[XB_XCNT(b.x)], 1u);
    return b;
}
__device__ __forceinline__ void xcd_barrier_complete(unsigned* bar, unsigned x, unsigned& nloc, unsigned& nx) {
    const unsigned G = gridDim.x * gridDim.y * gridDim.z;
    unsigned sum, cnt, mine, sp = 0u;
    for (;;) {
        sum = 0u; cnt = 0u; mine = 0u;
#pragma unroll
        for (unsigned j = 0; j < 16; ++j) { const unsigned c = xb_ld(&bar[XB_XCNT(j)]); sum += c; cnt += (c > 0u) ? 1u : 0u; mine = (j == x) ? c : mine; }
        if (sum == G) break;
        __builtin_amdgcn_s_sleep(1);
        if ((++sp & 255u) == 0u) { if (xb_ld(&bar[XB_TMO])) break; if (sp > XB_SPIN_CAP) { atomicAdd(&bar[XB_TMO], 1u); break; } }
    }
    nloc = mine > 0u ? mine : 1u; nx = cnt > 0u ? cnt : 1u;
}
__device__ __forceinline__ void xcd_barrier(const XcdBarrier& b) {
    asm volatile("s_waitcnt vmcnt(0)" ::: "memory");
    __syncthreads();
    if (threadIdx.x == 0) {
        unsigned* bar = b.bar;
        __builtin_amdgcn_s_waitcnt(0);
        unsigned nloc = b.st[0], nx = b.st[1];
        if (nloc == 0u) { xcd_barrier_complete(bar, b.x, nloc, nx); b.st[0] = nloc; b.st[1] = nx; }
        const unsigned old = xb_add(&bar[XB_XSUB(b.x)], 1u);
        const unsigned gen = old / nloc;
        if (old + 1u == (gen + 1u) * nloc) {
            __builtin_amdgcn_fence(__ATOMIC_RELEASE, "agent");
            asm volatile("s_waitcnt vmcnt(0)" ::: "memory");
            const unsigned og = xb_add(&bar[XB_TOP], 1u);
            const unsigned tg = og / nx;
            if (og + 1u == (tg + 1u) * nx) xb_add(&bar[XB_TOPGEN], 1u);
            else XB_SPIN(xb_ld(&bar[XB_TOPGEN]) == tg, bar);
            __builtin_amdgcn_fence(__ATOMIC_ACQUIRE, "agent");
            xb_add(&bar[XB_XGEN(b.x)], 1u);
            asm volatile("s_waitcnt vmcnt(0)" ::: "memory");
        } else {
            XB_SPIN(xb_ld(&bar[XB_XGEN(b.x)]) == gen, bar);
            __builtin_amdgcn_fence(__ATOMIC_ACQUIRE, "agent");
            asm volatile("s_waitcnt vmcnt(0)" ::: "memory");
        }
    }
    __syncthreads();
}

namespace pg8 {
#define PG8_LAS __attribute__((address_space(3)))
typedef unsigned short bf16_t;
typedef short bf16x8 __attribute__((ext_vector_type(8)));
typedef float f32x4 __attribute__((ext_vector_type(4)));
typedef unsigned u32x4 __attribute__((ext_vector_type(4)));
constexpr int BM = 256, BK = 64, HALF = 128, HTB = HALF * BK * 2  , STAGE_BYTES = 8 * HTB, NXCD = 8, WGM = 8;

__host__ __device__ __forceinline__ int lds_byte(int r, int c) { const int st = (r >> 4) * 2 + (c >> 5), rr = r & 15, cc = c & 31, ob = rr * 64 + cc * 2; return st * 1024 + (ob ^ (((ob >> 9) & 1) << 5)); }
__host__ __device__ __forceinline__ void stage_rc(int b, int& R, int& C) { const int st = b / 1024, sb = b % 1024, swz = sb ^ (((sb >> 9) & 1) << 5); R = (st >> 1) * 16 + swz / 64; C = (st & 1) * 32 + (swz % 64) / 2; }
__host__ __device__ __forceinline__ int perm32(int rho) { const int n = rho >> 4, i = rho & 15; return 8 * (i >> 2) + 4 * n + (i & 3); }

struct Unit { int pm, pn, sw; };
struct Gemm { const bf16_t* A; const bf16_t* Bt; int M, N, K; };

struct StaticOrder {
    int nM, nN, nwg, G, c;
    __host__ __device__ void init(int M, int N, int G_, int c_) { nM = M / BM; nN = N / BM; nwg = nM * nN; G = G_; c = c_; }
    __host__ __device__ bool next(int i, Unit& u) const {
        const long L = (long)i * G + c; if (L >= nwg) return false;
        int wgid = (int)L; { const int q = nwg / NXCD, r = nwg % NXCD, xcd = wgid % NXCD, off = wgid / NXCD; wgid = (xcd < r ? xcd * (q + 1) : r * (q + 1) + (xcd - r) * q) + off; }
        const int nig = WGM * nN, gid = wgid / nig, fm = gid * WGM, gsz = (nM - fm) < WGM ? (nM - fm) : WGM;
        u.pm = fm + ((wgid % nig) % gsz); u.pn = (wgid % nig) / gsz; u.sw = 0; return true;
    }
    __device__ __forceinline__ void a_ready(const Unit&) const {}
    __device__ __forceinline__ void done(const Unit&) const {}
};

struct ProjOrder : StaticOrder {
    __device__ bool next(int i, Unit& u) const { if (!StaticOrder::next(i, u)) return false; u.sw = (u.pn >= 44) ? 1 : 0; return true; }
};
typedef float f32x2 __attribute__((ext_vector_type(2)));
typedef __bf16 bf16x2_t __attribute__((ext_vector_type(2)));
__device__ __forceinline__ unsigned cvt_pk_bf16(float lo, float hi) { f32x2 v = {lo, hi}; bf16x2_t b = __builtin_convertvector(v, bf16x2_t); return __builtin_bit_cast(unsigned, b); }
__device__ __forceinline__ float bflo(unsigned w) { return __uint_as_float(w << 16); }
__device__ __forceinline__ float bfhi(unsigned w) { return __uint_as_float(w & 0xffff0000u); }
struct EpiF32 {
    static constexpr bool PERM = false, AFTER_DRAIN = false;
    float* C; int ldc;
    __device__ __forceinline__ void operator()(const f32x4 (&acc)[2][2][4][2], const Unit& u, int wr, int wc, int fr, int fq) const {
        const int row0 = u.pm * BM + wr * 64 + fr, col0 = u.pn * BM + wc * 32 + 4 * fq;
#pragma unroll
        for (int ai = 0; ai < 2; ++ai)
#pragma unroll
            for (int m = 0; m < 4; ++m) { float* rowp = C + (size_t)(row0 + ai * HALF + m * 16) * ldc + col0;
#pragma unroll
                for (int bj = 0; bj < 2; ++bj)
#pragma unroll
                    for (int n = 0; n < 2; ++n) *(f32x4*)(rowp + bj * HALF + n * 16) = acc[ai][bj][m][n]; }
    }
};
struct EpiRelu2 {
    static constexpr bool PERM = true, AFTER_DRAIN = false;
    bf16_t* O; int ldc;
    __device__ __forceinline__ void operator()(const f32x4 (&acc)[2][2][4][2], const Unit& u, int wr, int wc, int fr, int fq) const {
        const int row0 = u.pm * BM + wr * 64 + fr, col0 = u.pn * BM + wc * 32 + 8 * fq;
#pragma unroll
        for (int ai = 0; ai < 2; ++ai)
#pragma unroll
            for (int m = 0; m < 4; ++m) { bf16_t* rowp = O + (size_t)(row0 + ai * HALF + m * 16) * ldc + col0;
#pragma unroll
                for (int bj = 0; bj < 2; ++bj) { f32x4 v0 = acc[ai][bj][m][0], v1 = acc[ai][bj][m][1];
                    v0 = __builtin_elementwise_max(v0, (f32x4){0.f, 0.f, 0.f, 0.f}); v1 = __builtin_elementwise_max(v1, (f32x4){0.f, 0.f, 0.f, 0.f}); v0 = v0 * v0; v1 = v1 * v1;
                    u32x4 w; w.x = cvt_pk_bf16(v0[0], v0[1]); w.y = cvt_pk_bf16(v0[2], v0[3]); w.z = cvt_pk_bf16(v1[0], v1[1]); w.w = cvt_pk_bf16(v1[2], v1[3]);
                    *(u32x4*)(rowp + bj * HALF) = w; } }
    }
};
struct EpiGateA {
    static constexpr bool PERM = true, AFTER_DRAIN = false;
    float* TMP; const bf16_t* GA; int ldc;
    __device__ __forceinline__ void operator()(const f32x4 (&acc)[2][2][4][2], const Unit& u, int wr, int wc, int fr, int fq) const {
        const int row0 = u.pm * BM + wr * 64 + fr, col0 = u.pn * BM + wc * 32 + 8 * fq;
#pragma unroll
        for (int ai = 0; ai < 2; ++ai)
#pragma unroll
            for (int m = 0; m < 4; ++m) { const size_t ro = (size_t)(row0 + ai * HALF + m * 16) * ldc + col0;
#pragma unroll
                for (int bj = 0; bj < 2; ++bj) { const u32x4 g = *(const u32x4*)(GA + ro + bj * HALF); const f32x4 v0 = acc[ai][bj][m][0], v1 = acc[ai][bj][m][1];
                    const f32x4 o0 = {v0[0] * bflo(g.x), v0[1] * bfhi(g.x), v0[2] * bflo(g.y), v0[3] * bfhi(g.y)}, o1 = {v1[0] * bflo(g.z), v1[1] * bfhi(g.z), v1[2] * bflo(g.w), v1[3] * bfhi(g.w)};
                    *(f32x4*)(TMP + ro + bj * HALF) = o0; *(f32x4*)(TMP + ro + bj * HALF + 4) = o1; } }
    }
};
struct EpiGateB {
    static constexpr bool PERM = true, AFTER_DRAIN = false;
    const float* TMP; const bf16_t* GB; bf16_t* MIX; int ldc;
    __device__ __forceinline__ void operator()(const f32x4 (&acc)[2][2][4][2], const Unit& u, int wr, int wc, int fr, int fq) const {
        const int row0 = u.pm * BM + wr * 64 + fr, col0 = u.pn * BM + wc * 32 + 8 * fq;
#pragma unroll
        for (int ai = 0; ai < 2; ++ai)
#pragma unroll
            for (int m = 0; m < 4; ++m) { const size_t ro = (size_t)(row0 + ai * HALF + m * 16) * ldc + col0;
#pragma unroll
                for (int bj = 0; bj < 2; ++bj) { const u32x4 g = *(const u32x4*)(GB + ro + bj * HALF); const f32x4 t0 = *(const f32x4*)(TMP + ro + bj * HALF), t1 = *(const f32x4*)(TMP + ro + bj * HALF + 4);
                    const f32x4 v0 = acc[ai][bj][m][0], v1 = acc[ai][bj][m][1];
                    u32x4 w; w.x = cvt_pk_bf16(t0[0] + v0[0] * bflo(g.x), t0[1] + v0[1] * bfhi(g.x)); w.y = cvt_pk_bf16(t0[2] + v0[2] * bflo(g.y), t0[3] + v0[3] * bfhi(g.y));
                    w.z = cvt_pk_bf16(t1[0] + v1[0] * bflo(g.z), t1[1] + v1[1] * bfhi(g.z)); w.w = cvt_pk_bf16(t1[2] + v1[2] * bflo(g.w), t1[3] + v1[3] * bfhi(g.w));
                    *(u32x4*)(MIX + ro + bj * HALF) = w; } }
    }
};
struct EpiProj {
    static constexpr bool PERM = true, AFTER_DRAIN = false;
    bf16_t *QA, *RA, *QB, *KB, *GA, *GB, *KAT, *VAT, *VBT;
    __device__ __forceinline__ void operator()(const f32x4 (&acc)[2][2][4][2], const Unit& u, int wr, int wc, int fr, int fq) const {
        const int wt = u.pn; bf16_t* base; int ldc = 2048, t0; float sc = 1.f; int act = 0;
        if (wt < 4) { base = QA; ldc = 1024; t0 = 0; sc = 0.0625f; }
        else if (wt < 12) { base = RA; t0 = 4; act = 1; }
        else if (wt < 20) { base = QB; t0 = 12; sc = 0.08838834764831845f; }
        else if (wt < 28) { base = KB; t0 = 20; }
        else if (wt < 36) { base = GA; t0 = 28; act = 2; }
        else if (wt < 44) { base = GB; t0 = 36; act = 2; }
        else if (wt < 48) { base = KAT; t0 = 44; ldc = 8192; }
        else if (wt < 56) { base = VAT; t0 = 48; ldc = 8192; }
        else { base = VBT; t0 = 56; ldc = 8192; }
        const int rt = u.sw ? (wt - t0) : u.pm, ct = u.sw ? u.pm : (wt - t0);
        const int row0 = rt * BM + wr * 64 + fr, col0 = ct * BM + wc * 32 + 8 * fq;
#pragma unroll
        for (int ai = 0; ai < 2; ++ai)
#pragma unroll
            for (int m = 0; m < 4; ++m) { bf16_t* rowp = base + (size_t)(row0 + ai * HALF + m * 16) * ldc + col0;
#pragma unroll
                for (int bj = 0; bj < 2; ++bj) { float v[8];
#pragma unroll
                    for (int j = 0; j < 4; ++j) { v[j] = acc[ai][bj][m][0][j] * sc; v[4 + j] = acc[ai][bj][m][1][j] * sc; }
                    if (act) {
#pragma unroll
                        for (int j = 0; j < 8; ++j) { const float s = __builtin_amdgcn_rcpf(1.f + __expf(-v[j])); v[j] = (act == 1) ? v[j] * s : s; } }
                    u32x4 w; w.x = cvt_pk_bf16(v[0], v[1]); w.y = cvt_pk_bf16(v[2], v[3]); w.z = cvt_pk_bf16(v[4], v[5]); w.w = cvt_pk_bf16(v[6], v[7]);
                    *(u32x4*)(rowp + bj * HALF) = w; } }
    }
};

template <class Epi, class Sched, bool ALIGN_EPI = false, bool SP2 = false>
__device__ __forceinline__ void gemm_phase(PG8_LAS unsigned char* lds, const Gemm g, const Sched& S, const Epi& E) {
    int tid_ = threadIdx.x; asm volatile("" : "+v"(tid_));
    const int tid = tid_, wid = __builtin_amdgcn_readfirstlane(tid >> 6), lane = tid & 63, wr = wid >> 2, wc = wid & 3, fr = lane & 15, fq = lane >> 4;
    const int K = g.K, nt = K / BK;
    unsigned voffA[2], voffB[2];
#pragma unroll
    for (int i = 0; i < 2; ++i) { int R, C; stage_rc(tid * 16 + i * 8192, R, C); const int Rb = Epi::PERM ? ((R & ~31) + perm32(R & 31)) : R;
        voffA[i] = (unsigned)(R * K + C) * 2u; voffB[i] = (unsigned)(Rb * K + C) * 2u; }
    const size_t kstep = (size_t)(BK * 2);
    const size_t hstep = (size_t)HALF * K * 2;
    const size_t tstep = 2 * hstep;
    const unsigned ldsw = (unsigned)wid * 1024u;
    const int aoff = lds_byte(wr * 64 + fr, fq * 8), boff = lds_byte(wc * 32 + fr, fq * 8);
#define PG8_SA(b, h) (((b) * 2 + (h)) * HTB)
#define PG8_SB(b, h) ((4 + (b) * 2 + (h)) * HTB)
#define PG8_STAGE(bufoff, gbase, voff) do { _Pragma("unroll") for (int _i = 0; _i < 2; ++_i) \
        __builtin_amdgcn_global_load_lds((const unsigned*)((const char*)(gbase) + (voff)[_i]), (PG8_LAS unsigned*)(lds + (bufoff) + ldsw + _i * 8192), 16, 0, 0); } while (0)
#define PG8_LDA(dst, b, h) do { _Pragma("unroll") for (int m = 0; m < 4; ++m) _Pragma("unroll") for (int k = 0; k < 2; ++k) dst[m][k] = *(const PG8_LAS bf16x8*)(lds + PG8_SA(b, h) + aoff + m * 2048 + k * 1024); } while (0)
#define PG8_LDB(dst, b, h) do { _Pragma("unroll") for (int n = 0; n < 2; ++n) _Pragma("unroll") for (int k = 0; k < 2; ++k) dst[n][k] = *(const PG8_LAS bf16x8*)(lds + PG8_SB(b, h) + boff + n * 2048 + k * 1024); } while (0)
#define PG8_MMA(ai, bj, At, Bt) do { __builtin_amdgcn_s_setprio(1); _Pragma("unroll") for (int m = 0; m < 4; ++m) _Pragma("unroll") for (int n = 0; n < 2; ++n) _Pragma("unroll") for (int k = 0; k < 2; ++k) \
        acc[ai][bj][m][n] = __builtin_amdgcn_mfma_f32_16x16x32_bf16(Bt[n][k], At[m][k], acc[ai][bj][m][n], 0, 0, 0); __builtin_amdgcn_s_setprio(0); } while (0)
#define PG8_WAIT_V(n) asm volatile("s_waitcnt vmcnt(" #n ")" ::: "memory")
#define PG8_WAIT_L(n) asm volatile("s_waitcnt lgkmcnt(" #n ")" ::: "memory")
#define PG8_BAR __builtin_amdgcn_s_barrier()
#define PG8_SCHED __builtin_amdgcn_sched_barrier(0)
    Unit cur, nxt; int ui = 0;
    if (!S.next(0, cur)) return;
    f32x4 acc[2][2][4][2];
#pragma unroll
    for (int a = 0; a < 2; ++a)
#pragma unroll
        for (int b = 0; b < 2; ++b)
#pragma unroll
            for (int m = 0; m < 4; ++m)
#pragma unroll
                for (int n = 0; n < 2; ++n) acc[a][b][m][n] = (f32x4){0.f, 0.f, 0.f, 0.f};
    bf16x8 At[4][2], B0[2][2], B1[2][2];
    const char* cA = cur.sw ? (const char*)g.Bt + (size_t)cur.pn * tstep : (const char*)g.A + (size_t)cur.pm * tstep; const char* cB = cur.sw ? (const char*)g.A + (size_t)cur.pm * tstep : (const char*)g.Bt + (size_t)cur.pn * tstep;
    S.a_ready(cur);
    if constexpr (SP2) {
        PG8_STAGE(PG8_SB(0, 0), cB, voffB); PG8_STAGE(PG8_SB(0, 1), cB + hstep, voffB); PG8_STAGE(PG8_SA(0, 0), cA, voffA); PG8_STAGE(PG8_SA(0, 1), cA + hstep, voffA);
        if (wr == 1) PG8_BAR;
        PG8_WAIT_V(2); PG8_BAR;
        PG8_STAGE(PG8_SB(1, 0), cB + kstep, voffB); PG8_STAGE(PG8_SA(1, 0), cA + kstep, voffA); PG8_STAGE(PG8_SB(1, 1), cB + hstep + kstep, voffB);
        PG8_WAIT_V(6); PG8_BAR;
    } else {
        PG8_STAGE(PG8_SB(0, 0), cB, voffB); PG8_STAGE(PG8_SA(0, 0), cA, voffA); PG8_STAGE(PG8_SB(0, 1), cB + hstep, voffB); PG8_STAGE(PG8_SA(0, 1), cA + hstep, voffA);
        if (wr == 1) PG8_BAR;
        PG8_WAIT_V(4); PG8_BAR;
        PG8_STAGE(PG8_SB(1, 0), cB + kstep, voffB); PG8_STAGE(PG8_SA(1, 0), cA + kstep, voffA); PG8_STAGE(PG8_SB(1, 1), cB + hstep + kstep, voffB);
        PG8_WAIT_V(6); PG8_BAR;
    }
    for (;;) {
        const bool has_next = S.next(ui + 1, nxt);
        const char* nA = has_next ? (nxt.sw ? (const char*)g.Bt + (size_t)nxt.pn * tstep : (const char*)g.A + (size_t)nxt.pm * tstep) : cA; const char* nB = has_next ? (nxt.sw ? (const char*)g.A + (size_t)nxt.pm * tstep : (const char*)g.Bt + (size_t)nxt.pn * tstep) : cB;
        for (int t = 0; t < nt; t += 2) {
            const bool last = (t == nt - 2);
            const char* a1 = cA + (size_t)(t + 1) * kstep;
            const char* a2 = last ? nA : cA + (size_t)(t + 2) * kstep; const char* b2 = last ? nB : cB + (size_t)(t + 2) * kstep;
            const char* a3 = a2 + kstep; const char* b3 = b2 + kstep;
            if (last && has_next) S.a_ready(nxt);
            if constexpr (SP2) {
            PG8_LDB(B0, 0, 0); PG8_LDB(B1, 0, 1); PG8_SCHED; PG8_LDA(At, 0, 0); PG8_STAGE(PG8_SA(1, 1), a1 + hstep, voffA);
            PG8_WAIT_V(8); PG8_WAIT_L(0); PG8_BAR; PG8_MMA(0, 0, At, B0); PG8_MMA(0, 1, At, B1); PG8_BAR; PG8_SCHED;
            PG8_LDA(At, 0, 1); PG8_STAGE(PG8_SB(0, 0), b2, voffB); PG8_STAGE(PG8_SB(0, 1), b2 + hstep, voffB); PG8_STAGE(PG8_SA(0, 0), a2, voffA);
            PG8_WAIT_V(8); PG8_WAIT_L(0); PG8_BAR; PG8_MMA(1, 0, At, B0); PG8_MMA(1, 1, At, B1); PG8_BAR; PG8_SCHED;
            PG8_LDB(B0, 1, 0); PG8_LDB(B1, 1, 1); PG8_SCHED; PG8_LDA(At, 1, 0); PG8_STAGE(PG8_SA(0, 1), a2 + hstep, voffA);
            PG8_WAIT_V(8); PG8_WAIT_L(0); PG8_BAR; PG8_MMA(0, 0, At, B0); PG8_MMA(0, 1, At, B1); PG8_BAR; PG8_SCHED;
            PG8_LDA(At, 1, 1); PG8_STAGE(PG8_SB(1, 0), b3, voffB); PG8_STAGE(PG8_SB(1, 1), b3 + hstep, voffB); PG8_STAGE(PG8_SA(1, 0), a3, voffA);
            PG8_WAIT_V(8); PG8_WAIT_L(0); PG8_BAR; PG8_MMA(1, 0, At, B0); PG8_MMA(1, 1, At, B1); PG8_BAR; PG8_SCHED;
            } else {
            PG8_LDB(B0, 0, 0); PG8_SCHED; PG8_LDA(At, 0, 0); PG8_STAGE(PG8_SA(1, 1), a1 + hstep, voffA);
            PG8_WAIT_L(8); PG8_BAR; PG8_WAIT_L(0); PG8_MMA(0, 0, At, B0); PG8_BAR; PG8_SCHED;
            PG8_LDB(B1, 0, 1); PG8_STAGE(PG8_SB(0, 0), b2, voffB);
            PG8_BAR; PG8_WAIT_L(0); PG8_MMA(0, 1, At, B1); PG8_BAR;
            PG8_LDA(At, 0, 1); PG8_STAGE(PG8_SA(0, 0), a2, voffA);
            PG8_BAR; PG8_WAIT_L(0); PG8_MMA(1, 0, At, B0); PG8_BAR; PG8_SCHED;
            PG8_STAGE(PG8_SB(0, 1), b2 + hstep, voffB);
            PG8_WAIT_V(6); PG8_BAR; PG8_MMA(1, 1, At, B1); PG8_BAR;
            PG8_LDB(B0, 1, 0); PG8_SCHED; PG8_LDA(At, 1, 0); PG8_STAGE(PG8_SA(0, 1), a2 + hstep, voffA);
            PG8_WAIT_L(8); PG8_BAR; PG8_WAIT_L(0); PG8_MMA(0, 0, At, B0); PG8_BAR; PG8_SCHED;
            PG8_LDB(B1, 1, 1); PG8_STAGE(PG8_SB(1, 0), b3, voffB);
            PG8_BAR; PG8_WAIT_L(0); PG8_MMA(0, 1, At, B1); PG8_BAR;
            PG8_LDA(At, 1, 1); PG8_STAGE(PG8_SA(1, 0), a3, voffA);
            PG8_BAR; PG8_WAIT_L(0); PG8_MMA(1, 0, At, B0); PG8_BAR; PG8_SCHED;
            PG8_STAGE(PG8_SB(1, 1), b3 + hstep, voffB);
            PG8_WAIT_V(6); PG8_BAR; PG8_MMA(1, 1, At, B1); PG8_BAR;
            }
        }
        if constexpr (ALIGN_EPI) { if (wr == 0) PG8_BAR; }
        if constexpr (!Epi::AFTER_DRAIN) { E(acc, cur, wr, wc, fr, fq); S.done(cur); }
        if (!has_next) break;
#pragma unroll
        for (int a = 0; a < 2; ++a)
#pragma unroll
            for (int b = 0; b < 2; ++b)
#pragma unroll
                for (int m = 0; m < 4; ++m)
#pragma unroll
                    for (int n = 0; n < 2; ++n) acc[a][b][m][n] = (f32x4){0.f, 0.f, 0.f, 0.f};
        cur = nxt; cA = nA; cB = nB; ++ui;
        if constexpr (ALIGN_EPI) { if (wr == 1) PG8_BAR; }
    }
    PG8_WAIT_V(0);
    if constexpr (!ALIGN_EPI) { if (wr == 0) PG8_BAR; }
    PG8_BAR;
    if constexpr (Epi::AFTER_DRAIN) { E.fused(acc, cur, wr, wc, fr, fq, lds, wid, lane); S.done(cur); }
#undef PG8_SA
#undef PG8_SB
#undef PG8_STAGE
#undef PG8_LDA
#undef PG8_LDB
#undef PG8_MMA
#undef PG8_WAIT_V
#undef PG8_WAIT_L
#undef PG8_BAR
#undef PG8_SCHED
}
}

struct Frame {
    LAS unsigned char* lds;
    int tid, lane, wave, G, bx;
    const float *x, *c, *w_ada, *b_ada, *ng, *w_in, *w_gu, *b_gate, *gn, *w_go, *w_so, *w_out, *w_ff1, *w_ff2;
    float* out; unsigned char* ws;
};
#define WSP(T, off) ((T*)(F.ws + (off)))

template <class Epi>
__device__ __forceinline__ void gold_gemm(Frame& F, const bf16* A, int lda, const float* W, int ldw, int Mrows, int N, int K, const Epi& epi) {
    const int gw = F.bx * NWAVES + F.wave, ngw = F.G * NWAVES, lane = F.lane, r = lane & 31, h = lane >> 5;
    const int tm = Mrows / 64, tn = (N + 63) / 64;
    for (int u = gw; u < tm * tn; u += ngw) {
        const int m0 = (u / tn) * 64, n0 = (u % tn) * 64;
        f32x16 acc[2][2];
#pragma unroll
        for (int i = 0; i < 2; ++i)
#pragma unroll
            for (int j = 0; j < 2; ++j)
#pragma unroll
                for (int e = 0; e < 16; ++e) acc[i][j][e] = 0.f;
        const int nc0 = (n0 + r < N) ? n0 + r : N - 1, nc1 = (n0 + 32 + r < N) ? n0 + 32 + r : N - 1;
        const bf16* a0p = A + (size_t)(m0 + r) * lda + 8 * h; const bf16* a1p = A + (size_t)(m0 + 32 + r) * lda + 8 * h;
        for (int k0 = 0; k0 < K; k0 += 16) {
            const bf16x8 a0 = *(const bf16x8*)(a0p + k0), a1 = *(const bf16x8*)(a1p + k0);
            bf16x8 b0, b1;
#pragma unroll
            for (int j = 0; j < 8; ++j) { const float* wr = W + (size_t)(k0 + 8 * h + j) * ldw; b0[j] = (short)f2bf(wr[nc0]); b1[j] = (short)f2bf(wr[nc1]); }
            acc[0][0] = __builtin_amdgcn_mfma_f32_32x32x16_bf16(a0, b0, acc[0][0], 0, 0, 0);
            acc[0][1] = __builtin_amdgcn_mfma_f32_32x32x16_bf16(a0, b1, acc[0][1], 0, 0, 0);
            acc[1][0] = __builtin_amdgcn_mfma_f32_32x32x16_bf16(a1, b0, acc[1][0], 0, 0, 0);
            acc[1][1] = __builtin_amdgcn_mfma_f32_32x32x16_bf16(a1, b1, acc[1][1], 0, 0, 0);
        }
#pragma unroll
        for (int i = 0; i < 2; ++i)
#pragma unroll
            for (int j = 0; j < 2; ++j)
#pragma unroll
                for (int e = 0; e < 16; ++e) { const int row = m0 + 32 * i + (e & 3) + 8 * (e >> 2) + 4 * h, col = n0 + 32 * j + r; if (col < N) epi(row, col, acc[i][j][e]); }
    }
}
struct GEpiProj { bf16 *QA, *RA, *QB, *KB, *GA, *GB, *KAT, *VAT, *VBT;
    __device__ __forceinline__ void operator()(int row, int col, float v) const {
        if (col < C_KA) QA[(size_t)row * GK + col] = (bf16)f2bf(v * 0.0625f);
        else if (col < C_VA) KAT[(size_t)(col - C_KA) * MTOK + row] = (bf16)f2bf(v);
        else if (col < C_RA) VAT[(size_t)(col - C_VA) * MTOK + row] = (bf16)f2bf(v);
        else if (col < C_AL) RA[(size_t)row * GV + col - C_RA] = (bf16)f2bf(v * sigmoidf_(v));
        else if (col < C_QB) { }
        else if (col < C_KB) QB[(size_t)row * DM + col - C_QB] = (bf16)f2bf(v * 0.08838834764831845f);
        else if (col < C_VB) KB[(size_t)row * DM + col - C_KB] = (bf16)f2bf(v);
        else if (col < C_GA) VBT[(size_t)(col - C_VB) * MTOK + row] = (bf16)f2bf(v);
        else if (col < C_GB) GA[(size_t)row * DM + col - C_GA] = (bf16)f2bf(sigmoidf_(v));
        else GB[(size_t)row * DM + col - C_GB] = (bf16)f2bf(sigmoidf_(v));
    } };
struct GEpiGateA { float* TMP; const bf16* GA; __device__ __forceinline__ void operator()(int row, int col, float v) const { const size_t i = (size_t)row * DM + col; TMP[i] = v * bf2f(GA[i]); } };
struct GEpiGateB { const float* TMP; const bf16* GB; bf16* MIX; __device__ __forceinline__ void operator()(int row, int col, float v) const { const size_t i = (size_t)row * DM + col; MIX[i] = (bf16)f2bf(TMP[i] + v * bf2f(GB[i])); } };
struct GEpiF32 { float* C; int ldc; __device__ __forceinline__ void operator()(int row, int col, float v) const { C[(size_t)row * ldc + col] = v; } };
struct GEpiRelu2 { bf16* O; int ldc; __device__ __forceinline__ void operator()(int row, int col, float v) const { const float t = fmaxf(v, 0.f); O[(size_t)row * ldc + col] = (bf16)f2bf(t * t); } };

__device__ __forceinline__ void p0_mod(Frame& F) {
    LAS float* cact = (LAS float*)F.lds;
    LAS float* red = (LAS float*)(F.lds + 32768);
    for (int i = F.tid; i < NB * DM; i += NTHR) { const float v = F.c[i]; cact[i] = v * sigmoidf_(v); }
    __syncthreads();
    float* MOD = WSP(float, WS_MOD);
    for (int u = F.bx; u < DEPTH * 48; u += F.G) {
        const int l = u / 48, n0 = (u % 48) * 256;
        const float* W = F.w_ada + (size_t)l * DM * (6 * DM) + n0 + 4 * F.lane;
        f32x4 acc[4];
#pragma unroll
        for (int b = 0; b < 4; ++b) acc[b] = (f32x4){0.f, 0.f, 0.f, 0.f};
        const int kb = F.wave * 256;
#pragma unroll 8
        for (int k = 0; k < 256; ++k) {
            const f32x4 wv = *(const f32x4*)(W + (size_t)(kb + k) * (6 * DM));
#pragma unroll
            for (int b = 0; b < 4; ++b) acc[b] += cact[b * DM + kb + k] * wv;
        }
#pragma unroll
        for (int b = 0; b < 4; ++b) *(LAS f32x4*)(red + (F.wave * 4 + b) * 256 + 4 * F.lane) = acc[b];
        __syncthreads();
#pragma unroll
        for (int i = 0; i < 2; ++i) {
            const int o = F.tid * 2 + i, b = o >> 8, col = o & 255; float s = F.b_ada[(size_t)l * 6 * DM + n0 + col];
#pragma unroll
            for (int w = 0; w < 8; ++w) s += red[(w * 4 + b) * 256 + col];
            MOD[(size_t)(l * NB + b) * (6 * DM) + n0 + col] = s;
        }
        __syncthreads();
    }
}

__device__ __forceinline__ int win_src_col(int d) {
    if (d < 1024) return C_QA + d;
    if (d < 3072) return C_RA + d - 1024;
    if (d < 5120) return C_QB + d - 3072;
    if (d < 7168) return C_KB + d - 5120;
    if (d < 9216) return C_GA + d - 7168;
    if (d < 11264) return C_GB + d - 9216;
    if (d < 12288) return C_KA + d - 11264;
    if (d < 14336) return C_VA + d - 12288;
    return C_VB + d - 14336;
}
__device__ __forceinline__ void tr_item(const float* src, int lds_, bf16* dst, int ldd, LAS float* scr, int lane) {
#pragma unroll 8
    for (int i = 0; i < 32; ++i) { const int kk = 2 * i + (lane >> 5); scr[kk * 33 + (lane & 31)] = src[(size_t)kk * lds_ + (lane & 31)]; }
    LDS_WAIT(); asm volatile("" ::: "memory");
    const int c = lane & 7;
#pragma unroll
    for (int j = 0; j < 4; ++j) { const int n = (lane >> 3) + 8 * j; const LAS float* s = scr + (8 * c) * 33 + n;
        v4u o; o.x = pk2(s[0 * 33], s[1 * 33]); o.y = pk2(s[2 * 33], s[3 * 33]); o.z = pk2(s[4 * 33], s[5 * 33]); o.w = pk2(s[6 * 33], s[7 * 33]);
        *(v4u*)(dst + (size_t)n * ldd + 8 * c) = o; }
    LDS_WAIT(); asm volatile("" ::: "memory");
}
__device__ __forceinline__ void p0_transposes(Frame& F) {
    LAS float* scr = (LAS float*)(F.lds + F.wave * 16384);
    const int gw = F.bx * NWAVES + F.wave, ngw = F.G * NWAVES, lane = F.lane;
    constexpr int I_IN = 32 * 512, I_SQ = 32 * 64, I_F1 = 32 * 256, I_F2 = 128 * 64, I_L = I_IN + 3 * I_SQ + I_F1 + I_F2;
    for (int it = gw; it < DEPTH * I_L; it += ngw) {
        const int l = it / I_L; int r = it % I_L; unsigned char* wl = F.ws + WS_W + (size_t)l * WL_STRIDE;
        if (r < I_IN) { const int kb = r / 512, d0 = (r % 512) * 32;
            tr_item(F.w_in + (size_t)l * DM * INCOLS + (size_t)(kb * 64) * INCOLS + win_src_col(d0), INCOLS, (bf16*)(wl + WL_IN) + (size_t)d0 * DM + kb * 64, DM, scr, lane); continue; }
        r -= I_IN;
        if (r < I_SQ) { const int kb = r / 64, n0 = (r % 64) * 32;
            tr_item(F.w_go + (size_t)l * DM * DM + (size_t)(kb * 64) * DM + n0, DM, (bf16*)(wl + WL_GO) + (size_t)n0 * DM + kb * 64, DM, scr, lane); continue; }
        r -= I_SQ;
        if (r < I_SQ) { const int kb = r / 64, n0 = (r % 64) * 32;
            tr_item(F.w_so + (size_t)l * DM * DM + (size_t)(kb * 64) * DM + n0, DM, (bf16*)(wl + WL_SO) + (size_t)n0 * DM + kb * 64, DM, scr, lane); continue; }
        r -= I_SQ;
        if (r < I_SQ) { const int kb = r / 64, n0 = (r % 64) * 32;
            tr_item(F.w_out + (size_t)l * DM * DM + (size_t)(kb * 64) * DM + n0, DM, (bf16*)(wl + WL_OUT) + (size_t)n0 * DM + kb * 64, DM, scr, lane); continue; }
        r -= I_SQ;
        if (r < I_F1) { const int kb = r / 256, n0 = (r % 256) * 32;
            tr_item(F.w_ff1 + (size_t)l * DM * DFF + (size_t)(kb * 64) * DFF + n0, DFF, (bf16*)(wl + WL_FF1) + (size_t)n0 * DM + kb * 64, DM, scr, lane); continue; }
        r -= I_F1;
        { const int kb = r / 64, n0 = (r % 64) * 32;
            tr_item(F.w_ff2 + (size_t)l * DFF * DM + (size_t)(kb * 64) * DM + n0, DM, (bf16*)(wl + WL_FF2) + (size_t)n0 * DFF + kb * 64, DFF, scr, lane); }
    }
}

__device__ __forceinline__ void p0_wa(Frame& F) {
    bf16* WA = WSP(bf16, WS_WA);
    for (int i = F.bx * NTHR + F.tid; i < DEPTH * RANK * DM; i += F.G * NTHR) { const int l = i / (RANK * DM), r = (i / DM) % RANK, k = i % DM;
        WA[i] = (bf16)f2bf(F.w_in[(size_t)l * DM * INCOLS + (size_t)k * INCOLS + C_AL + r]); }
}

__device__ __forceinline__ void row_load(const float* p, int lane, f32x4 (&v)[8]) {
#pragma unroll
    for (int j = 0; j < 8; ++j) v[j] = *(const f32x4*)(p + 256 * j + 4 * lane);
}
__device__ __forceinline__ float row_rstd(const f32x4 (&v)[8]) {
    float s = 0.f;
#pragma unroll
    for (int j = 0; j < 8; ++j) s += (v[j].x * v[j].x + v[j].y * v[j].y) + (v[j].z * v[j].z + v[j].w * v[j].w);
    return rsqrtf(wave_sum(s) * (1.f / DM) + EPS);
}
__device__ __forceinline__ void row_emit_h(const f32x4 (&x)[8], const float* ng, const float* sc, const float* sh, bf16* hrow, int lane) {
    const float rs = row_rstd(x);
#pragma unroll
    for (int j = 0; j < 8; ++j) {
        const int o = 256 * j + 4 * lane;
        const f32x4 g = *(const f32x4*)(ng + o), s = *(const f32x4*)(sc + o), t = *(const f32x4*)(sh + o);
        const f32x4 hv = x[j] * rs * g * (1.f + s) + t;
        v2u w; w.x = pk2(hv.x, hv.y); w.y = pk2(hv.z, hv.w);
        *(v2u*)(hrow + o) = w;
    }
}
template <int MODE> __device__ __forceinline__ void row_phase(Frame& F, int l) {
    const int gw = F.bx * NWAVES + F.wave, ngw = F.G * NWAVES, lane = F.lane;
    const float* MOD = WSP(float, WS_MOD); bf16* H = WSP(bf16, WS_H); const float* M2 = WSP(float, WS_M2);
    for (int m = gw; m < MTOK; m += ngw) {
        const int b = m / SEQ; const float* modp = MOD + (size_t)(l * NB + b) * (6 * DM);
        f32x4 x[8];
        if (MODE == 0) {
            row_load(F.x + (size_t)m * DM, lane, x);
            row_emit_h(x, F.ng + (size_t)(l * 4 + 0) * DM, modp + DM, modp, H + (size_t)m * DM, lane);
        } else {
            const float* xs = ((MODE == 1 && l == 0) ? F.x : F.out) + (size_t)m * DM;
            row_load(xs, lane, x);
            f32x4 y[8]; row_load(M2 + (size_t)m * DM, lane, y);
            const float rs = row_rstd(y);
            const float* g = modp + (MODE == 1 ? 2 * DM : 5 * DM); const float* ngy = F.ng + (size_t)(l * 4 + (MODE == 1 ? 1 : 3)) * DM;
#pragma unroll
            for (int j = 0; j < 8; ++j) { const int o = 256 * j + 4 * lane; const f32x4 gv = *(const f32x4*)(g + o), nv = *(const f32x4*)(ngy + o);
                x[j] = x[j] + gv * (y[j] * rs * nv); *(f32x4*)(F.out + (size_t)m * DM + o) = x[j]; }
            if (MODE == 1) row_emit_h(x, F.ng + (size_t)(l * 4 + 2) * DM, modp + 4 * DM, modp + 3 * DM, H + (size_t)m * DM, lane);
            else if (l + 1 < DEPTH) { const float* modn = MOD + (size_t)((l + 1) * NB + b) * (6 * DM);
                row_emit_h(x, F.ng + (size_t)((l + 1) * 4 + 0) * DM, modn + DM, modn, H + (size_t)m * DM, lane); }
        }
    }
}

__device__ __forceinline__ void gcalc(Frame& F, int l) {
    LAS float* al = (LAS float*)F.lds;
    const bf16* H = WSP(bf16, WS_H); bf16* GT = WSP(bf16, WS_GT); float* DEC = WSP(float, WS_DEC);
    for (int u = F.bx; u < 256; u += F.G) {
        const int cc = u >> 1, kd = (u & 1) * 512 + F.tid;
        if (FAST_GCALC) {
            LAS float* part = (LAS float*)(F.lds + 8192);
            const int tb = F.wave & 3, kh = F.wave >> 2, lane = F.lane;
            const bf16* ap = H + (size_t)(cc * 64 + tb * 16 + (lane & 15)) * DM + kh * 1024 + 8 * (lane >> 4);
            const bf16* bp = WSP(bf16, WS_WA) + (size_t)(l * RANK + (lane & 15)) * DM + kh * 1024 + 8 * (lane >> 4);
            f32x4 acc = {0.f, 0.f, 0.f, 0.f};
#pragma unroll 8
            for (int i = 0; i < 32; ++i) { const v4u a = *(const v4u*)(ap + 32 * i), bb = *(const v4u*)(bp + 32 * i);
                acc = __builtin_amdgcn_mfma_f32_16x16x32_bf16(__builtin_bit_cast(bf16x8, a), __builtin_bit_cast(bf16x8, bb), acc, 0, 0, 0); }
#pragma unroll
            for (int e = 0; e < 4; ++e) part[(kh * 64 + tb * 16 + (lane >> 4) * 4 + e) * 16 + (lane & 15)] = acc[e];
            __syncthreads();
            for (int i = F.tid; i < 1024; i += NTHR) al[i] = part[i] + part[1024 + i];
        } else
        {
            const int t = F.tid >> 3, r0 = (F.tid & 7) * 2; float a0 = 0.f, a1 = 0.f;
            const bf16* hp = H + (size_t)(cc * 64 + t) * DM; const float* wp = F.w_in + (size_t)l * DM * INCOLS + C_AL + r0;
            for (int k0 = 0; k0 < DM; k0 += 8) {
                const v4u hv = *(const v4u*)(hp + k0);
                const float hh[8] = {bf2f(hv.x & 0xffffu), bf2f(hv.x >> 16), bf2f(hv.y & 0xffffu), bf2f(hv.y >> 16), bf2f(hv.z & 0xffffu), bf2f(hv.z >> 16), bf2f(hv.w & 0xffffu), bf2f(hv.w >> 16)};
#pragma unroll
                for (int i = 0; i < 8; ++i) { const f32x2 w = *(const f32x2*)(wp + (size_t)(k0 + i) * INCOLS); a0 += hh[i] * bf2f(f2bf(w.x)); a1 += hh[i] * bf2f(f2bf(w.y)); }
            }
            al[t * 16 + r0] = a0; al[t * 16 + r0 + 1] = a1;
        }
        __syncthreads();
        float wg[16];
#pragma unroll
        for (int r = 0; r < 16; ++r) wg[r] = F.w_gu[(size_t)(l * RANK + r) * GK + kd];
        const float bg = F.b_gate[(size_t)l * GK + kd];
        float la[64];
#pragma unroll
        for (int t = 0; t < 64; ++t) { float s = bg;
#pragma unroll
            for (int r = 0; r < 16; ++r) s += al[t * 16 + r] * wg[r];
            la[t] = logsig(s) * 0.0625f; }
        float suf = 0.f;
#pragma unroll
        for (int t8 = 7; t8 >= 0; --t8) { float g[8];
#pragma unroll
            for (int i = 7; i >= 0; --i) { g[i] = __expf(suf); suf += la[t8 * 8 + i]; }
            v4u w; w.x = pk2(g[0], g[1]); w.y = pk2(g[2], g[3]); w.z = pk2(g[4], g[5]); w.w = pk2(g[6], g[7]);
            *(v4u*)(GT + (size_t)kd * MTOK + cc * 64 + t8 * 8) = w; }
        DEC[(size_t)cc * GK + kd] = __expf(suf);
        __syncthreads();
    }
}

__device__ __forceinline__ void gla_gold(Frame& F) {
    LAS float* S = (LAS float*)F.lds;
    LAS float* vv = (LAS float*)(F.lds + 33792);
    LAS bf16* kp = (LAS bf16*)(F.lds + 33792 + 8320);
    LAS bf16* qq = (LAS bf16*)(F.lds + 33792 + 8320 + 33792);
    const bf16* KAT = WSP(bf16, WS_KAT); const bf16* GT = WSP(bf16, WS_GT); const bf16* VAT = WSP(bf16, WS_VAT); const bf16* QA = WSP(bf16, WS_QA);
    const float* DEC = WSP(float, WS_DEC); bf16* OG = WSP(bf16, WS_OG);
    for (int u = F.bx; u < 256; u += F.G) {
        const int b = u >> 6, hg = (u >> 4) & 3, vs = u & 15;
        for (int i = F.tid; i < 256 * 33; i += NTHR) S[i] = 0.f;
        __syncthreads();
        for (int c = 0; c < 32; ++c) {
            const int T0 = b * SEQ + c * 64, cc = b * 32 + c;
            { const int k = F.tid >> 1, t0 = (F.tid & 1) * 32; const size_t go = (size_t)(hg * GDK + k) * MTOK + T0 + t0;
#pragma unroll
              for (int i = 0; i < 32; ++i) kp[k * 66 + t0 + i] = (bf16)f2bf(bf2f(KAT[go + i]) * bf2f(GT[go + i])); }
            { const int v = F.tid >> 4, t0 = (F.tid & 15) * 4; const size_t go = (size_t)(hg * GDV + vs * 32 + v) * MTOK + T0 + t0;
#pragma unroll
              for (int i = 0; i < 4; ++i) vv[v * 65 + t0 + i] = bf2f(VAT[go + i]); }
            { const int t = F.tid >> 3, k0 = (F.tid & 7) * 32; const size_t go = (size_t)(T0 + t) * GK + hg * GDK + k0;
#pragma unroll
              for (int i = 0; i < 32; ++i) qq[t * 258 + k0 + i] = QA[go + i]; }
            __syncthreads();
#pragma unroll 1
            for (int i = 0; i < 16; ++i) { const int e = F.tid + 512 * i, k = e >> 5, v = e & 31;
                float acc = S[k * 33 + v] * DEC[(size_t)cc * GK + hg * GDK + k];
                for (int t = 0; t < 64; ++t) acc += bf2f(kp[k * 66 + t]) * vv[v * 65 + t];
                S[k * 33 + v] = acc; }
            __syncthreads();
#pragma unroll 1
            for (int i = 0; i < 4; ++i) { const int e = F.tid + 512 * i, t = e >> 5, v = e & 31; float acc = 0.f;
                for (int k = 0; k < 256; ++k) acc += bf2f(qq[t * 258 + k]) * S[k * 33 + v];
                OG[(size_t)(T0 + t) * GV + hg * GDV + vs * 32 + v] = (bf16)f2bf(acc); }
            __syncthreads();
        }
    }
}

__device__ __forceinline__ void sb_gold(Frame& F) {
    const int gw = F.bx * NWAVES + F.wave, ngw = F.G * NWAVES, lane = F.lane;
    const bf16* QB = WSP(bf16, WS_QB); const bf16* KB = WSP(bf16, WS_KB); const bf16* VBT = WSP(bf16, WS_VBT); bf16* SBO = WSP(bf16, WS_SBO);
    for (int rid = gw; rid < NB * SH * SEQ; rid += ngw) {
        const int t = rid % SEQ, bh = rid / SEQ, b = bh / SH, h = bh % SH;
        const unsigned qw = *(const unsigned*)(QB + (size_t)(b * SEQ + t) * DM + h * SDH + 2 * lane);
        const float q0 = bf2f(qw & 0xffffu), q1 = bf2f(qw >> 16);
        float o0 = 0.f, o1 = 0.f, P = 1.f;
        const bf16* v0p = VBT + (size_t)(h * SDH + 2 * lane) * MTOK + b * SEQ; const bf16* v1p = v0p + MTOK;
        for (int s = t - 1; s >= 0; --s) {
            if (P == 0.f) break;
            const unsigned kw = *(const unsigned*)(KB + (size_t)(b * SEQ + s) * DM + h * SDH + 2 * lane);
            float z = wave_sum(q0 * bf2f(kw & 0xffffu) + q1 * bf2f(kw >> 16));
            z = fminf(fmaxf(z, -80.f), 80.f);
            const float e = __expf(-z), beta = __builtin_amdgcn_rcpf(1.f + e), w = beta * P;
            P *= e * beta;
            o0 += w * bf2f(v0p[s]); o1 += w * bf2f(v1p[s]);
        }
        *(unsigned*)(SBO + (size_t)(b * SEQ + t) * DM + h * SDH + 2 * lane) = pk2(o0, o1);
    }
}

typedef __bf16 bf16x2v __attribute__((ext_vector_type(2)));
__device__ __forceinline__ unsigned cvtpk(float lo, float hi) { f32x2 v = {lo, hi}; bf16x2v b = __builtin_convertvector(v, bf16x2v); return __builtin_bit_cast(unsigned, b); }
__device__ __forceinline__ float blo(unsigned w) { return __uint_as_float(w << 16); }
__device__ __forceinline__ float bhi(unsigned w) { return __uint_as_float(w & 0xffff0000u); }
struct GlaRegs { v4u kA[4], gA[4], vB[4]; f32x4 dc[4]; v2u qA[2][2][2]; };
__device__ __forceinline__ void gla_load(GlaRegs& R, int c, const bf16* kp_, const bf16* gp_, const bf16* vp_, const float* dp_, const bf16* qp_) {
    const int T0 = c * 64;
#pragma unroll
    for (int s_ = 0; s_ < 4; ++s_) { R.kA[s_] = *(const v4u*)(kp_ + T0 + 16 * s_); R.gA[s_] = *(const v4u*)(gp_ + T0 + 16 * s_); R.vB[s_] = *(const v4u*)(vp_ + T0 + 16 * s_); R.dc[s_] = *(const f32x4*)(dp_ + (size_t)c * GK + 8 * s_); }
#pragma unroll
    for (int tb = 0; tb < 2; ++tb)
#pragma unroll
        for (int s2 = 0; s2 < 2; ++s2) { const bf16* q = qp_ + (size_t)(T0 + tb * 32) * GK + 16 * s2; R.qA[tb][s2][0] = *(const v2u*)q; R.qA[tb][s2][1] = *(const v2u*)(q + 8); }
}
__device__ __forceinline__ void gla_pin(GlaRegs& R) {
    asm volatile("" : "+v"(R.kA[0]), "+v"(R.kA[1]), "+v"(R.kA[2]), "+v"(R.kA[3]), "+v"(R.gA[0]), "+v"(R.gA[1]), "+v"(R.gA[2]), "+v"(R.gA[3]),
                      "+v"(R.vB[0]), "+v"(R.vB[1]), "+v"(R.vB[2]), "+v"(R.vB[3]), "+v"(R.dc[0]), "+v"(R.dc[1]), "+v"(R.dc[2]), "+v"(R.dc[3]));
    asm volatile("" : "+v"(R.qA[0][0][0]), "+v"(R.qA[0][0][1]), "+v"(R.qA[0][1][0]), "+v"(R.qA[0][1][1]), "+v"(R.qA[1][0][0]), "+v"(R.qA[1][0][1]), "+v"(R.qA[1][1][0]), "+v"(R.qA[1][1][1]));
}
__device__ __forceinline__ void gla_step(const GlaRegs& R, f32x16& S, int c, LAS float* Pl, bf16* og, int w, int r31, int hh, int tid) {
#pragma unroll
    for (int e = 0; e < 16; ++e) S[e] *= R.dc[e >> 2][e & 3];
#pragma unroll
    for (int s_ = 0; s_ < 4; ++s_) {
        v4u kpk;
        kpk.x = cvtpk(blo(R.kA[s_].x) * blo(R.gA[s_].x), bhi(R.kA[s_].x) * bhi(R.gA[s_].x)); kpk.y = cvtpk(blo(R.kA[s_].y) * blo(R.gA[s_].y), bhi(R.kA[s_].y) * bhi(R.gA[s_].y));
        kpk.z = cvtpk(blo(R.kA[s_].z) * blo(R.gA[s_].z), bhi(R.kA[s_].z) * bhi(R.gA[s_].z)); kpk.w = cvtpk(blo(R.kA[s_].w) * blo(R.gA[s_].w), bhi(R.kA[s_].w) * bhi(R.gA[s_].w));
        S = __builtin_amdgcn_mfma_f32_32x32x16_bf16(__builtin_bit_cast(bf16x8, kpk), __builtin_bit_cast(bf16x8, R.vB[s_]), S, 0, 0, 0);
    }
    v4u sf[2];
#pragma unroll
    for (int s2 = 0; s2 < 2; ++s2) { sf[s2].x = cvtpk(S[8 * s2 + 0], S[8 * s2 + 1]); sf[s2].y = cvtpk(S[8 * s2 + 2], S[8 * s2 + 3]); sf[s2].z = cvtpk(S[8 * s2 + 4], S[8 * s2 + 5]); sf[s2].w = cvtpk(S[8 * s2 + 6], S[8 * s2 + 7]); }
    LAS float* pl = Pl + (size_t)(c & 1) * 16384 + w * 2048;
#pragma unroll
    for (int tb = 0; tb < 2; ++tb) {
        f32x16 po;
#pragma unroll
        for (int e = 0; e < 16; ++e) po[e] = 0.f;
#pragma unroll
        for (int s2 = 0; s2 < 2; ++s2) { v4u a; a.x = R.qA[tb][s2][0].x; a.y = R.qA[tb][s2][0].y; a.z = R.qA[tb][s2][1].x; a.w = R.qA[tb][s2][1].y;
            po = __builtin_amdgcn_mfma_f32_32x32x16_bf16(__builtin_bit_cast(bf16x8, a), __builtin_bit_cast(bf16x8, sf[s2]), po, 0, 0, 0); }
#pragma unroll
        for (int e = 0; e < 16; ++e) pl[(tb * 32 + (e & 3) + 8 * (e >> 2) + 4 * hh) * 32 + r31] = po[e];
    }
    asm volatile("s_waitcnt lgkmcnt(0)" ::: "memory"); __builtin_amdgcn_s_barrier(); asm volatile("" ::: "memory");
    {   const int tok = tid >> 3, v4 = (tid & 7) * 4; const LAS float* rp = Pl + (size_t)(c & 1) * 16384 + tok * 32 + v4;
        f32x4 acc = *(const LAS f32x4*)rp;
#pragma unroll
        for (int ww = 1; ww < 8; ++ww) acc += *(const LAS f32x4*)(rp + ww * 2048);
        v2u o2; o2.x = cvtpk(acc.x, acc.y); o2.y = cvtpk(acc.z, acc.w);
        *(v2u*)(og + (size_t)(c * 64 + tok) * GV + v4) = o2; }
}
__device__ __forceinline__ void gla_fast(Frame& F) {
    LAS float* Pl = (LAS float*)F.lds;
    const bf16* KAT = WSP(bf16, WS_KAT); const bf16* GT = WSP(bf16, WS_GT); const bf16* VAT = WSP(bf16, WS_VAT); const bf16* QA = WSP(bf16, WS_QA);
    const float* DEC = WSP(float, WS_DEC); bf16* OG = WSP(bf16, WS_OG);
    const int lane = F.lane, w = F.wave, r31 = lane & 31, hh = lane >> 5, tid = F.tid;
    for (int u = F.bx; u < 256; u += F.G) {
        const int b = u >> 6, hg = (u >> 4) & 3, vs = u & 15;
        f32x16 S;
#pragma unroll
        for (int e = 0; e < 16; ++e) S[e] = 0.f;
        const bf16* kp_ = KAT + (size_t)(hg * GDK + 32 * w + r31) * MTOK + b * SEQ + 8 * hh;
        const bf16* gp_ = GT + (size_t)(hg * GDK + 32 * w + r31) * MTOK + b * SEQ + 8 * hh;
        const bf16* vp_ = VAT + (size_t)(hg * GDV + vs * 32 + r31) * MTOK + b * SEQ + 8 * hh;
        const float* dp_ = DEC + (size_t)(b * 32) * GK + hg * GDK + 32 * w + 4 * hh;
        const bf16* qp_ = QA + (size_t)(b * SEQ + r31) * GK + hg * GDK + 32 * w + 4 * hh;
        bf16* og = OG + (size_t)(b * SEQ) * GV + hg * GDV + vs * 32;
        GlaRegs R0, R1;
        gla_load(R0, 0, kp_, gp_, vp_, dp_, qp_);
        for (int c = 0; c < 32; c += 2) {
            gla_pin(R0); __builtin_amdgcn_sched_barrier(0);
            gla_load(R1, c + 1, kp_, gp_, vp_, dp_, qp_); __builtin_amdgcn_sched_barrier(0);
            gla_step(R0, S, c, Pl, og, w, r31, hh, tid);
            gla_pin(R1); __builtin_amdgcn_sched_barrier(0);
            if (c + 2 < 32) gla_load(R0, c + 2, kp_, gp_, vp_, dp_, qp_);
            __builtin_amdgcn_sched_barrier(0);
            gla_step(R1, S, c + 1, Pl, og, w, r31, hh, tid);
        }
        __syncthreads();
    }
}

__device__ __forceinline__ void sb_fast(Frame& F) {
    LAS unsigned char* Kt = F.lds;
    LAS unsigned char* Vt = F.lds + 2 * 17408;
    volatile LAS unsigned* flg = (volatile LAS unsigned*)(F.lds + 4 * 17408);
    const bf16* QB = WSP(bf16, WS_QB); const bf16* KB = WSP(bf16, WS_KB); const bf16* VBT = WSP(bf16, WS_VBT); bf16* SBO = WSP(bf16, WS_SBO);
    const int lane = F.lane, wave = F.wave, r31 = lane & 31, hh = lane >> 5, tid = F.tid;
    for (int u = F.bx; u < 512; u += F.G) {
        const int bh = u >> 3, qb = u & 7, b = bh >> 4, h = bh & 15;
        const int t = qb * 256 + 32 * wave + r31, twmax = qb * 256 + 32 * wave + 31;
        v4u qf[8];
        { const bf16* qp = QB + (size_t)(b * SEQ + t) * DM + h * SDH + 8 * hh;
#pragma unroll
          for (int s_ = 0; s_ < 8; ++s_) qf[s_] = *(const v4u*)(qp + 16 * s_); }
        f32x16 o[4];
#pragma unroll
        for (int d = 0; d < 4; ++d)
#pragma unroll
            for (int e = 0; e < 16; ++e) o[d][e] = 0.f;
        float P = 1.f;
        const int kt_hi = qb * 4 + 3;
        const int c0 = tid, c1 = tid + 512;
        const bf16* kg0 = KB + (size_t)(b * SEQ + (c0 >> 4)) * DM + h * SDH + (c0 & 15) * 8; const bf16* kg1 = KB + (size_t)(b * SEQ + (c1 >> 4)) * DM + h * SDH + (c1 & 15) * 8;
        const bf16* vg0 = VBT + (size_t)(h * SDH + (c0 >> 3)) * MTOK + b * SEQ + (c0 & 7) * 8; const bf16* vg1 = VBT + (size_t)(h * SDH + (c1 >> 3)) * MTOK + b * SEQ + (c1 & 7) * 8;
        const int kl0 = (c0 >> 4) * 272 + (c0 & 15) * 16, kl1 = (c1 >> 4) * 272 + (c1 & 15) * 16, vl0 = (c0 >> 3) * 136 + (c0 & 7) * 16, vl1 = (c1 >> 3) * 136 + (c1 & 7) * 16;
        v4u rk0, rk1, rv0, rv1;
        rk0 = *(const v4u*)(kg0 + (size_t)kt_hi * 64 * DM); rk1 = *(const v4u*)(kg1 + (size_t)kt_hi * 64 * DM); rv0 = *(const v4u*)(vg0 + kt_hi * 64); rv1 = *(const v4u*)(vg1 + kt_hi * 64);
        *(LAS v4u*)(Kt + kl0) = rk0; *(LAS v4u*)(Kt + kl1) = rk1;
        *(LAS v2u*)(Vt + vl0) = (v2u){rv0.x, rv0.y}; *(LAS v2u*)(Vt + vl0 + 8) = (v2u){rv0.z, rv0.w}; *(LAS v2u*)(Vt + vl1) = (v2u){rv1.x, rv1.y}; *(LAS v2u*)(Vt + vl1 + 8) = (v2u){rv1.z, rv1.w};
        __syncthreads();
        int it = 0;
        for (int kt = kt_hi; kt >= 0; --kt, ++it) {
            const int buf = it & 1;
            if (kt > 0) { rk0 = *(const v4u*)(kg0 + (size_t)(kt - 1) * 64 * DM); rk1 = *(const v4u*)(kg1 + (size_t)(kt - 1) * 64 * DM); rv0 = *(const v4u*)(vg0 + (kt - 1) * 64); rv1 = *(const v4u*)(vg1 + (kt - 1) * 64); }
            const bool alive = __builtin_amdgcn_ballot_w64(P != 0.f) != 0ull;
            if (alive && kt * 64 < twmax) {
                const LAS unsigned char* kb_ = Kt + buf * 17408 + r31 * 272 + 16 * hh;
                f32x16 sa[2];
#pragma unroll
                for (int kb = 0; kb < 2; ++kb) {
#pragma unroll
                    for (int e = 0; e < 16; ++e) sa[kb][e] = 0.f;
#pragma unroll
                    for (int s_ = 0; s_ < 8; ++s_) { const v4u a = *(const LAS v4u*)(kb_ + kb * 32 * 272 + 32 * s_);
                        sa[kb] = __builtin_amdgcn_mfma_f32_32x32x16_bf16(__builtin_bit_cast(bf16x8, a), __builtin_bit_cast(bf16x8, qf[s_]), sa[kb], 0, 0, 0); }
                }
                float run = P; v4u pf[2][2];
#pragma unroll
                for (int kb = 1; kb >= 0; --kb) {
                    float be[16], om[16];
#pragma unroll
                    for (int e = 0; e < 16; ++e) { const int key = kt * 64 + kb * 32 + (e & 3) + 8 * (e >> 2) + 4 * hh;
                        const float z = fminf(fmaxf(sa[kb][e], -80.f), 80.f), ex = __expf(-z), bt = __builtin_amdgcn_rcpf(1.f + ex); const bool msk = key >= t;
                        be[e] = msk ? 0.f : bt; om[e] = msk ? 1.f : ex * bt; }
                    float wv[16];
#pragma unroll
                    for (int g = 3; g >= 0; --g) {
                        const float x2 = om[4 * g + 3], x1 = x2 * om[4 * g + 2], x0 = x1 * om[4 * g + 1], Gp = x0 * om[4 * g], Pp = __shfl_xor(Gp, 32);
                        const float ag = hh == 0 ? run * Pp : run;
                        wv[4 * g + 3] = be[4 * g + 3] * ag; wv[4 * g + 2] = be[4 * g + 2] * (x2 * ag); wv[4 * g + 1] = be[4 * g + 1] * (x1 * ag); wv[4 * g] = be[4 * g] * (x0 * ag);
                        run *= Gp * Pp; }
#pragma unroll
                    for (int s2 = 0; s2 < 2; ++s2) { pf[kb][s2].x = cvtpk(wv[8 * s2], wv[8 * s2 + 1]); pf[kb][s2].y = cvtpk(wv[8 * s2 + 2], wv[8 * s2 + 3]); pf[kb][s2].z = cvtpk(wv[8 * s2 + 4], wv[8 * s2 + 5]); pf[kb][s2].w = cvtpk(wv[8 * s2 + 6], wv[8 * s2 + 7]); }
                }
                P = run;
                const LAS unsigned char* vb_ = Vt + buf * 17408 + r31 * 136 + 8 * hh;
#pragma unroll
                for (int d = 0; d < 4; ++d)
#pragma unroll
                    for (int kb = 0; kb < 2; ++kb)
#pragma unroll
                        for (int s2 = 0; s2 < 2; ++s2) { const LAS unsigned char* p = vb_ + d * 32 * 136 + (kb * 32 + 16 * s2) * 2; const v2u lo = *(const LAS v2u*)p, hi = *(const LAS v2u*)(p + 16);
                            const v4u a = {lo.x, lo.y, hi.x, hi.y};
                            o[d] = __builtin_amdgcn_mfma_f32_32x32x16_bf16(__builtin_bit_cast(bf16x8, a), __builtin_bit_cast(bf16x8, pf[kb][s2]), o[d], 0, 0, 0); }
            }
            if (lane == 0) flg[buf * 8 + wave] = (__builtin_amdgcn_ballot_w64(P != 0.f) == 0ull) ? 1u : 0u;
            if (kt > 0) { const int nb = (buf ^ 1) * 17408;
                *(LAS v4u*)(Kt + nb + kl0) = rk0; *(LAS v4u*)(Kt + nb + kl1) = rk1;
                *(LAS v2u*)(Vt + nb + vl0) = (v2u){rv0.x, rv0.y}; *(LAS v2u*)(Vt + nb + vl0 + 8) = (v2u){rv0.z, rv0.w}; *(LAS v2u*)(Vt + nb + vl1) = (v2u){rv1.x, rv1.y}; *(LAS v2u*)(Vt + nb + vl1 + 8) = (v2u){rv1.z, rv1.w}; }
            __syncthreads();
            unsigned nd = 0;
#pragma unroll
            for (int i = 0; i < 8; ++i) nd += flg[buf * 8 + i];
            if (nd == 8u) break;
        }
        { bf16* op = SBO + (size_t)(b * SEQ + t) * DM + h * SDH + 4 * hh;
#pragma unroll
          for (int d = 0; d < 4; ++d)
#pragma unroll
              for (int g = 0; g < 4; ++g) { v2u w2; w2.x = cvtpk(o[d][4 * g], o[d][4 * g + 1]); w2.y = cvtpk(o[d][4 * g + 2], o[d][4 * g + 3]); *(v2u*)(op + d * 32 + 8 * g) = w2; } }
        __syncthreads();
    }
}

__device__ __forceinline__ void gla_gate(Frame& F, int l) {
    const int gw = F.bx * NWAVES + F.wave, ngw = F.G * NWAVES, lane = F.lane;
    const bf16* OG = WSP(bf16, WS_OG); const bf16* RA = WSP(bf16, WS_RA); bf16* GIN = WSP(bf16, WS_GIN);
    for (int m = gw; m < MTOK; m += ngw) {
#pragma unroll
        for (int hg = 0; hg < 4; ++hg) {
            const size_t o = (size_t)m * GV + hg * GDV + 8 * lane;
            const v4u ov = *(const v4u*)(OG + o), rv = *(const v4u*)(RA + o);
            float x[8]; x[0] = bf2f(ov.x & 0xffffu); x[1] = bf2f(ov.x >> 16); x[2] = bf2f(ov.y & 0xffffu); x[3] = bf2f(ov.y >> 16);
            x[4] = bf2f(ov.z & 0xffffu); x[5] = bf2f(ov.z >> 16); x[6] = bf2f(ov.w & 0xffffu); x[7] = bf2f(ov.w >> 16);
            float r[8]; r[0] = bf2f(rv.x & 0xffffu); r[1] = bf2f(rv.x >> 16); r[2] = bf2f(rv.y & 0xffffu); r[3] = bf2f(rv.y >> 16);
            r[4] = bf2f(rv.z & 0xffffu); r[5] = bf2f(rv.z >> 16); r[6] = bf2f(rv.w & 0xffffu); r[7] = bf2f(rv.w >> 16);
            float s = 0.f;
#pragma unroll
            for (int i = 0; i < 8; ++i) s += x[i] * x[i];
            const float rs = rsqrtf(wave_sum(s) * (1.f / GDV) + EPS);
            const float* gp = F.gn + (size_t)(l * GH + hg) * GDV + 8 * lane;
            const f32x4 g0 = *(const f32x4*)gp, g1 = *(const f32x4*)(gp + 4);
            const float gg[8] = {g0.x, g0.y, g0.z, g0.w, g1.x, g1.y, g1.z, g1.w};
            float y[8];
#pragma unroll
            for (int i = 0; i < 8; ++i) y[i] = x[i] * rs * gg[i] * r[i];
            v4u w; w.x = pk2(y[0], y[1]); w.y = pk2(y[2], y[3]); w.z = pk2(y[4], y[5]); w.w = pk2(y[6], y[7]);
            *(v4u*)(GIN + o) = w;
        }
    }
}

constexpr int NPHASE = 2 + 9 * DEPTH;
struct Args { const float* in[14]; float* out; unsigned char* ws; int ph_lo, ph_hi, use_bar, pad; };
__global__ void __launch_bounds__(NTHR, 2) fwd(Args args) {
    extern __shared__ __attribute__((aligned(16))) unsigned char lds[];
    Frame F;
    F.lds = (LAS unsigned char*)lds; F.tid = threadIdx.x; F.lane = F.tid & 63; F.wave = __builtin_amdgcn_readfirstlane(F.tid >> 6); F.G = gridDim.x; F.bx = blockIdx.x;
    F.x = args.in[0]; F.c = args.in[1]; F.w_ada = args.in[2]; F.b_ada = args.in[3]; F.ng = args.in[4]; F.w_in = args.in[5]; F.w_gu = args.in[6]; F.b_gate = args.in[7];
    F.gn = args.in[8]; F.w_go = args.in[9]; F.w_so = args.in[10]; F.w_out = args.in[11]; F.w_ff1 = args.in[12]; F.w_ff2 = args.in[13]; F.out = args.out; F.ws = args.ws;
    volatile LAS unsigned* MISC = (volatile LAS unsigned*)(F.lds + MISC_OFF);
    for (int u = F.tid; u < (LDS_BYTES - LDSCTL_OFF) / 4; u += NTHR) ((LAS unsigned*)(F.lds + LDSCTL_OFF))[u] = 0u;
    __syncthreads();
    XcdBarrier bar; bar.bar = (unsigned*)(F.ws + WS_CTL) + CW_BAR; bar.x = 0; bar.st = nullptr;
    if (args.use_bar) bar = xcd_barrier_post((unsigned*)(F.ws + WS_CTL) + CW_BAR, MISC + 8);
    const int lo = args.ph_lo, hi = args.ph_hi;
#define IN(k) (lo <= (k) && (k) < hi)
#define SEAM(k) do { if (IN(k) && IN((k) + 1)) xcd_barrier(bar); } while (0)

    if (IN(0)) { for (int rep = 0; rep < ((DUP & 1) ? 2 : 1); ++rep) { p0_mod(F); if (FAST_GEMM) p0_transposes(F); p0_wa(F); __syncthreads(); } } SEAM(0);
    if (IN(1)) { row_phase<0>(F, 0); } SEAM(1);
    for (int l = 0; l < DEPTH; ++l) {
        const int pb = 2 + 9 * l;
        { int t_ = threadIdx.x; asm volatile("" : "+v"(t_)); F.tid = t_; F.lane = t_ & 63; }
        if (IN(pb + 0)) {
            for (int rep = 0; rep < ((DUP & 2) ? 2 : 1); ++rep) gcalc(F, l);
            for (int rep = 0; rep < ((DUP & 4) ? 2 : 1); ++rep)
            if (FAST_GEMM & 1) {
                __syncthreads();
                pg8::Gemm g{WSP(bf16, WS_H), (const bf16*)(F.ws + WS_W + (size_t)l * WL_STRIDE + WL_IN), MTOK, 16384, DM}; pg8::ProjOrder S; S.init(MTOK, 16384, F.G, F.bx);
                pg8::EpiProj E{WSP(bf16, WS_QA), WSP(bf16, WS_RA), WSP(bf16, WS_QB), WSP(bf16, WS_KB), WSP(bf16, WS_GA), WSP(bf16, WS_GB), WSP(bf16, WS_KAT), WSP(bf16, WS_VAT), WSP(bf16, WS_VBT)};
                pg8::gemm_phase<pg8::EpiProj, pg8::ProjOrder, true, true>(F.lds, g, S, E);
            } else {
            GEpiProj E{WSP(bf16, WS_QA), WSP(bf16, WS_RA), WSP(bf16, WS_QB), WSP(bf16, WS_KB), WSP(bf16, WS_GA), WSP(bf16, WS_GB), WSP(bf16, WS_KAT), WSP(bf16, WS_VAT), WSP(bf16, WS_VBT)};
            gold_gemm(F, WSP(bf16, WS_H), DM, F.w_in + (size_t)l * DM * INCOLS, INCOLS, MTOK, INCOLS, DM, E);
            }
        } SEAM(pb + 0);
        if (IN(pb + 1)) {
            for (int rep = 0; rep < ((DUP & 8) ? 2 : 1); ++rep) { if (FAST_GLA) gla_fast(F); else gla_gold(F); __syncthreads(); }
            for (int rep = 0; rep < ((DUP & 256) ? 2 : 1); ++rep) { if (FAST_SB) sb_fast(F); else sb_gold(F); __syncthreads(); }
        } SEAM(pb + 1);
        if (IN(pb + 2)) { for (int rep = 0; rep < ((DUP & 16) ? 2 : 1); ++rep) gla_gate(F, l); } SEAM(pb + 2);
        if (IN(pb + 3)) {
            for (int rep = 0; rep < ((DUP & 32) ? 2 : 1); ++rep)
            if (FAST_GEMM & 2) {
                const unsigned char* wl = F.ws + WS_W + (size_t)l * WL_STRIDE;
                { pg8::Gemm g{WSP(bf16, WS_GIN), (const bf16*)(wl + WL_GO), MTOK, DM, GV}; pg8::StaticOrder S; S.init(MTOK, DM, F.G, F.bx);
                  pg8::EpiGateA E{WSP(float, WS_TMP), WSP(bf16, WS_GA), DM}; pg8::gemm_phase<pg8::EpiGateA, pg8::StaticOrder, false, true>(F.lds, g, S, E); }
                { pg8::Gemm g{WSP(bf16, WS_SBO), (const bf16*)(wl + WL_SO), MTOK, DM, DM}; pg8::StaticOrder S; S.init(MTOK, DM, F.G, F.bx);
                  pg8::EpiGateB E{WSP(float, WS_TMP), WSP(bf16, WS_GB), WSP(bf16, WS_MIX), DM}; pg8::gemm_phase<pg8::EpiGateB, pg8::StaticOrder, false, true>(F.lds, g, S, E); }
            } else {
            GEpiGateA EA{WSP(float, WS_TMP), WSP(bf16, WS_GA)};
            gold_gemm(F, WSP(bf16, WS_GIN), GV, F.w_go + (size_t)l * GV * DM, DM, MTOK, DM, GV, EA);
            GEpiGateB EB{WSP(float, WS_TMP), WSP(bf16, WS_GB), WSP(bf16, WS_MIX)};
            gold_gemm(F, WSP(bf16, WS_SBO), DM, F.w_so + (size_t)l * DM * DM, DM, MTOK, DM, DM, EB);
            }
        } SEAM(pb + 3);
        if (IN(pb + 4)) {
            for (int rep = 0; rep < ((DUP & 32) ? 2 : 1); ++rep)
            if (FAST_GEMM & 4) {
                pg8::Gemm g{WSP(bf16, WS_MIX), (const bf16*)(F.ws + WS_W + (size_t)l * WL_STRIDE + WL_OUT), MTOK, DM, DM}; pg8::StaticOrder S; S.init(MTOK, DM, F.G, F.bx);
                pg8::EpiF32 E{WSP(float, WS_M2), DM}; pg8::gemm_phase<pg8::EpiF32, pg8::StaticOrder, false, true>(F.lds, g, S, E);
            } else {
            GEpiF32 E{WSP(float, WS_M2), DM};
            gold_gemm(F, WSP(bf16, WS_MIX), DM, F.w_out + (size_t)l * DM * DM, DM, MTOK, DM, DM, E);
            }
        } SEAM(pb + 4);
        if (IN(pb + 5)) { row_phase<1>(F, l); } SEAM(pb + 5);
        if (IN(pb + 6)) {
            for (int rep = 0; rep < ((DUP & 64) ? 2 : 1); ++rep)
            if (FAST_GEMM & 8) {
                pg8::Gemm g{WSP(bf16, WS_H), (const bf16*)(F.ws + WS_W + (size_t)l * WL_STRIDE + WL_FF1), MTOK, DFF, DM}; pg8::StaticOrder S; S.init(MTOK, DFF, F.G, F.bx);
                pg8::EpiRelu2 E{WSP(bf16, WS_F1), DFF}; pg8::gemm_phase<pg8::EpiRelu2, pg8::StaticOrder, true, true>(F.lds, g, S, E);
            } else {
            GEpiRelu2 E{WSP(bf16, WS_F1), DFF};
            gold_gemm(F, WSP(bf16, WS_H), DM, F.w_ff1 + (size_t)l * DM * DFF, DFF, MTOK, DFF, DM, E);
            }
        } SEAM(pb + 6);
        if (IN(pb + 7)) {
            for (int rep = 0; rep < ((DUP & 64) ? 2 : 1); ++rep)
            if (FAST_GEMM & 16) {
                pg8::Gemm g{WSP(bf16, WS_F1), (const bf16*)(F.ws + WS_W + (size_t)l * WL_STRIDE + WL_FF2), MTOK, DM, DFF}; pg8::StaticOrder S; S.init(MTOK, DM, F.G, F.bx);
                pg8::EpiF32 E{WSP(float, WS_M2), DM}; pg8::gemm_phase<pg8::EpiF32, pg8::StaticOrder, false, true>(F.lds, g, S, E);
            } else {
            GEpiF32 E{WSP(float, WS_M2), DM};
            gold_gemm(F, WSP(bf16, WS_F1), DFF, F.w_ff2 + (size_t)l * DFF * DM, DM, MTOK, DM, DFF, E);
            }
        } SEAM(pb + 7);
        if (IN(pb + 8)) { row_phase<2>(F, l); } SEAM(pb + 8);
    }
#undef IN
#undef SEAM
}

extern "C" void kernel_launch(void* const* d_in, const int* in_sizes, int n_in, void* d_out, int out_size, void* d_ws, size_t ws_size, hipStream_t stream) {
    static int grid = 0;
    if (grid == 0) {
        if (n_in != 14 || out_size != MTOK * DM || ws_size < WS_END) { fprintf(stderr, "kernel_launch: unexpected shapes (n_in %d out %d ws %zu)\n", n_in, out_size, ws_size); grid = -1; return; }
        int dev = 0, cus = 0, per_cu = 0;
        if (hipGetDevice(&dev) != hipSuccess || hipDeviceGetAttribute(&cus, hipDeviceAttributeMultiprocessorCount, dev) != hipSuccess) { grid = -1; return; }
        if (hipFuncSetAttribute((const void*)fwd, hipFuncAttributeMaxDynamicSharedMemorySize, LDS_BYTES) != hipSuccess) { fprintf(stderr, "kernel_launch: hipFuncSetAttribute failed\n"); grid = -1; return; }
        if (hipOccupancyMaxActiveBlocksPerMultiprocessor(&per_cu, (const void*)fwd, NTHR, LDS_BYTES) != hipSuccess || per_cu < 1) fprintf(stderr, "kernel_launch: occupancy query says %d\n", per_cu);
        (void)hipGetLastError();
        grid = cus;
    }
    if (grid < 0) return;
    (void)hipMemsetAsync((char*)d_ws + WS_CTL, 0, CTL_ZERO_BYTES, stream);
    Args a{};
    for (int i = 0; i < 14; ++i) a.in[i] = (const float*)d_in[i];
    a.out = (float*)d_out; a.ws = (unsigned char*)d_ws;
#if N_LAUNCHES == 1
    a.ph_lo = 0; a.ph_hi = NPHASE; a.use_bar = 1;
    hipLaunchKernelGGL(fwd, dim3(grid), dim3(NTHR), LDS_BYTES, stream, a);
#else
    for (int p = 0; p < NPHASE; ++p) { a.ph_lo = p; a.ph_hi = p + 1; a.use_bar = 0; hipLaunchKernelGGL(fwd, dim3(grid), dim3(NTHR), LDS_BYTES, stream, a); }
#endif
}
```
